# Optimizing an MI355X kernel written in HIP

```python
import jax, jax.numpy as jnp
from jax import lax
import numpy as np

D_MODEL = 2048
BATCH = 4
SEQ = 2048
DEPTH = 2
DEC_BATCH = 128
DEC_SEQ = 8
PAST_LEN = 16384
PAGE_SIZE = 128

N_MIXERS = 2
N_A_LAYERS = (DEPTH + 1) // 2
N_B_LAYERS = DEPTH // 2
TOK_WIDTH = 3 * D_MODEL // 4
MEM_WIDTH = D_MODEL - TOK_WIDTH
MEM_HEADS = 4
MEM_HEAD_DIM = MEM_WIDTH // MEM_HEADS
N_MEM = 256
A_HEAD_DIM = 64
A_HEADS = TOK_WIDTH // A_HEAD_DIM
A_DECAY_RANK = 96
A_ICLR_RANK = 96
A_GATE_RANK = 256
A_SPLITS = (TOK_WIDTH, 2 * TOK_WIDTH, 3 * TOK_WIDTH, 3 * TOK_WIDTH + A_DECAY_RANK, 3 * TOK_WIDTH + A_DECAY_RANK + A_ICLR_RANK)
A_PROJ = 3 * TOK_WIDTH + A_DECAY_RANK + A_ICLR_RANK + A_GATE_RANK
B_EXPAND = 128
B_HEADS = TOK_WIDTH // B_EXPAND
B_HEAD_V = TOK_WIDTH // B_HEADS
B_PROJ = 4 * TOK_WIDTH
CHUNK = 64
D_FF = 5632
CONV_W = 3
RMS_EPS = 1e-6
GN_EPS = 64e-5

kernel_name = 'hybrid_rwkv7_hgrn2_memxattn_convffn_step'


def rmsnorm(x, g):
    xf = x.astype(jnp.float32)
    y = xf * lax.rsqrt(jnp.mean(xf * xf, axis=-1, keepdims=True) + RMS_EPS)
    return (y * g.astype(jnp.float32)).astype(x.dtype)


def memory_attend(q, mem_k, mem_v):
    s = jnp.einsum('bthd,bmhd->bhtm', q, mem_k).astype(jnp.float32) * (MEM_HEAD_DIM ** -0.5)
    p = jax.nn.softmax(s, axis=-1).astype(mem_v.dtype)
    o = jnp.einsum('bhtm,bmhd->bthd', p, mem_v)
    return o.reshape(q.shape[0], q.shape[1], MEM_WIDTH)


def rwkv7_mix(p, p_prev, s0, P, j):
    b, t, _ = p.shape
    f32 = jnp.float32
    xm = p + P['a_mu'][j] * (p_prev - p)
    r, k, v, xw, xa, xg = jnp.split(xm, A_SPLITS, axis=-1)
    w = -jax.nn.softplus(-(P['a_w0'][j] + jnp.tanh(xw) @ P['a_w2'][j])) - 0.5
    decay = jnp.exp(-jnp.exp(w.astype(f32)))
    a = jax.nn.sigmoid(P['a_a0'][j] + xa @ P['a_a2'][j])
    g = jax.nn.sigmoid(xg) @ P['a_g2'][j]
    heads = lambda z: z.astype(f32).reshape(b, t, A_HEADS, A_HEAD_DIM)
    kk = heads(k * P['a_k_k'][j])
    kk = kk * lax.rsqrt(jnp.maximum(jnp.sum(kk * kk, axis=-1, keepdims=True), 1e-24))
    k = k * (1.0 + (a - 1.0) * P['a_k_a'][j])
    r_h, k_h, v_h, a_h, d_h = heads(r), heads(k), heads(v), heads(a), heads(decay)

    def step(S, inp):
        r_t, k_t, v_t, kk_t, b_t, d_t = inp
        S = (S * d_t[:, :, None, :]
             - jnp.einsum('bhvk,bhk->bhv', S, kk_t)[..., None] * b_t[:, :, None, :]
             + v_t[..., None] * k_t[:, :, None, :])
        return S, jnp.einsum('bhvk,bhk->bhv', S, r_t)

    tm = lambda z: jnp.swapaxes(z, 0, 1)
    s_fin, y = lax.scan(step, s0.astype(f32), (tm(r_h), tm(k_h), tm(v_h), tm(kk), tm(kk * a_h), tm(d_h)))
    y = tm(y)
    mu = jnp.mean(y, axis=-1, keepdims=True)
    var = jnp.mean(jnp.square(y - mu), axis=-1, keepdims=True)
    yn = ((y - mu) * lax.rsqrt(var + GN_EPS)).reshape(b, t, TOK_WIDTH)
    yn = yn * P['a_ln_w'][j].astype(f32) + P['a_ln_b'][j].astype(f32)
    r_k = P['a_r_k'][j].astype(f32).reshape(A_HEADS, A_HEAD_DIM)
    bonus = (jnp.sum(r_h * k_h * r_k, axis=-1, keepdims=True) * v_h).reshape(b, t, TOK_WIDTH)
    out = (yn + bonus) * g.astype(f32)
    return out.astype(p.dtype), s_fin


def gla_chunked(q, k, v, log_f, s0):
    b, t, h, _ = q.shape
    vd = v.shape[-1]
    c = CHUNK if t % CHUNK == 0 else t
    n = t // c
    to_chunks = lambda z: z.astype(jnp.float32).reshape(b, n, c, h, z.shape[-1]).transpose(1, 0, 3, 2, 4)
    qc, kc, vc, gc = to_chunks(q), to_chunks(k), to_chunks(v), to_chunks(log_f)
    bc = jnp.cumsum(gc, axis=3)
    mask = jnp.tril(jnp.ones((c, c), dtype=bool))
    mid = (c - 1) // 2

    def step(S, inp):
        q_, k_, v_, b_ = inp
        m = b_[:, :, mid:mid + 1, :]
        att = jnp.einsum('bhtk,bhsk->bhts', q_ * jnp.exp(b_ - m), k_ * jnp.exp(m - b_))
        att = jnp.where(mask, att, 0.0)
        o = jnp.einsum('bhts,bhsv->bhtv', att, v_) + jnp.einsum('bhtk,bhkv->bhtv', q_ * jnp.exp(b_), S)
        b_last = b_[:, :, -1:, :]
        S = jnp.exp(b_last[:, :, 0, :])[..., None] * S + jnp.einsum('bhsk,bhsv->bhkv', k_ * jnp.exp(b_last - b_), v_)
        return S, o

    s_fin, o = lax.scan(step, s0.astype(jnp.float32), (qc, kc, vc, bc))
    o = o.transpose(1, 0, 3, 2, 4).reshape(b, t, h, vd)
    return o, s_fin


def hgrn2_mix(p, s0, lb, g_norm):
    b, t, _ = p.shape
    f32 = jnp.float32
    q, f, i, og = jnp.split(p, 4, axis=-1)
    fg = lb + (1.0 - lb) * jax.nn.sigmoid(f.astype(f32))
    heads = lambda z, d: z.astype(f32).reshape(b, t, B_HEADS, d)
    o, s_fin = gla_chunked(heads(jax.nn.silu(q), B_EXPAND), heads(1.0 - fg, B_EXPAND),
                           heads(i, B_HEAD_V), heads(jnp.log(fg), B_EXPAND), s0)
    o = rmsnorm(o, g_norm).reshape(b, t, TOK_WIDTH)
    out = o * jax.nn.silu(og.astype(f32))
    return out.astype(p.dtype), s_fin


def conv_ffn(h, buf, w_up, conv_w, conv_b, w_down):
    t = h.shape[1]
    a, v = jnp.split(h @ w_up, 2, axis=-1)
    a_ext = jnp.concatenate([buf.astype(a.dtype), a], axis=1)
    c = conv_b
    for tap in range(CONV_W):
        c = c + a_ext[:, tap:tap + t] * conv_w[tap]
    y = (jax.nn.gelu(c) * v) @ w_down
    return y, a_ext[:, t:]


def trunk(x, mem_k, mem_v, st_rwkv, st_shift, st_hgrn, st_conv, P):
    b, t, _ = x.shape
    lb_all = jnp.cumsum(jax.nn.softmax(P['b_lower_bounds'].astype(jnp.float32), axis=0), axis=0)
    lb_all = lb_all - lb_all[0]
    new_rwkv, new_shift, new_hgrn, new_conv = [], [], [], []
    for layer in range(DEPTH):
        j = layer // N_MIXERS
        h = rmsnorm(x, P['norm_mix'][layer])
        if layer % N_MIXERS == 0:
            h_ext = jnp.concatenate([st_shift[j][:, None, :].astype(h.dtype), h], axis=1)
            p_ext = h_ext @ P['a_w_in'][j]
            p = p_ext[:, 1:]
            tok, s_new = rwkv7_mix(p[..., MEM_WIDTH:], p_ext[:, :-1, MEM_WIDTH:], st_rwkv[j], P, j)
            new_rwkv.append(s_new)
            new_shift.append(h[:, -1])
            w_out = P['a_w_out'][j]
        else:
            p = h @ P['b_w_in'][j]
            tok, s_new = hgrn2_mix(p[..., MEM_WIDTH:], st_hgrn[j], lb_all[layer], P['b_g_norm'][j])
            new_hgrn.append(s_new)
            w_out = P['b_w_out'][j]
        q_mem = p[..., :MEM_WIDTH].reshape(b, t, MEM_HEADS, MEM_HEAD_DIM)
        mem_o = memory_attend(q_mem, mem_k[layer], mem_v[layer])
        x = x + jnp.concatenate([tok, mem_o.astype(tok.dtype)], axis=-1) @ w_out
        f, c_new = conv_ffn(rmsnorm(x, P['norm_ffn'][layer]), st_conv[layer], P['ffn_w_up'][layer],
                            P['ffn_conv_w'][layer], P['ffn_conv_b'][layer], P['ffn_w_down'][layer])
        new_conv.append(c_new)
        x = x + f
    return (rmsnorm(x, P['norm_final']), jnp.stack(new_rwkv), jnp.stack(new_shift),
            jnp.stack(new_hgrn), jnp.stack(new_conv))


def setup_inputs(seed: int = 0) -> dict:
    key = jax.random.key(seed)
    ks = iter(jax.random.split(key, 48))
    nrm = lambda shape, scale=1.0: jax.random.normal(next(ks), shape, jnp.float32) * scale
    uni = lambda shape, lo, hi: jax.random.uniform(next(ks), shape, jnp.float32, lo, hi)
    D = D_MODEL
    return {
        'x_prompt': nrm((BATCH, SEQ, D)),
        'x_sample': nrm((DEC_BATCH, DEC_SEQ, D)),
        'mem_prompt': nrm((BATCH, N_MEM, D)),
        'cache_mem_k': nrm((DEPTH, DEC_BATCH, N_MEM, MEM_HEADS, MEM_HEAD_DIM)),
        'cache_mem_v': nrm((DEPTH, DEC_BATCH, N_MEM, MEM_HEADS, MEM_HEAD_DIM)),
        'state_rwkv': nrm((N_A_LAYERS, DEC_BATCH, A_HEADS, A_HEAD_DIM, A_HEAD_DIM), 0.3),
        'state_shift': nrm((N_A_LAYERS, DEC_BATCH, D)),
        'state_hgrn': nrm((N_B_LAYERS, DEC_BATCH, B_HEADS, B_EXPAND, B_HEAD_V), 0.3),
        'state_conv': nrm((DEPTH, DEC_BATCH, CONV_W - 1, D_FF)),
        'norm_mix': 1.0 + nrm((DEPTH, D), 0.02),
        'norm_ffn': 1.0 + nrm((DEPTH, D), 0.02),
        'norm_final': 1.0 + nrm((D,), 0.02),
        'mem_norm': 1.0 + nrm((DEPTH, D), 0.02),
        'w_mem_kv': nrm((DEPTH, D, 2 * MEM_WIDTH), D ** -0.5),
        'a_w_in': nrm((N_A_LAYERS, D, MEM_WIDTH + A_PROJ), D ** -0.5),
        'a_mu': uni((N_A_LAYERS, A_PROJ), 0.0, 1.0),
        'a_w0': uni((N_A_LAYERS, TOK_WIDTH), -5.0, 0.0),
        'a_w2': nrm((N_A_LAYERS, A_DECAY_RANK, TOK_WIDTH), 0.1 * A_DECAY_RANK ** -0.5),
        'a_a0': nrm((N_A_LAYERS, TOK_WIDTH), 0.1),
        'a_a2': nrm((N_A_LAYERS, A_ICLR_RANK, TOK_WIDTH), 0.1 * A_ICLR_RANK ** -0.5),
        'a_g2': nrm((N_A_LAYERS, A_GATE_RANK, TOK_WIDTH), A_GATE_RANK ** -0.5),
        'a_k_k': 0.85 + nrm((N_A_LAYERS, TOK_WIDTH), 0.05),
        'a_k_a': 1.0 + nrm((N_A_LAYERS, TOK_WIDTH), 0.05),
        'a_r_k': nrm((N_A_LAYERS, TOK_WIDTH), 0.1),
        'a_ln_w': 1.0 + nrm((N_A_LAYERS, TOK_WIDTH), 0.02),
        'a_ln_b': nrm((N_A_LAYERS, TOK_WIDTH), 0.02),
        'a_w_out': nrm((N_A_LAYERS, D, D), D ** -0.5),
        'b_w_in': nrm((N_B_LAYERS, D, MEM_WIDTH + B_PROJ), D ** -0.5),
        'b_lower_bounds': nrm((DEPTH, TOK_WIDTH), 0.1),
        'b_g_norm': 1.0 + nrm((N_B_LAYERS, B_HEAD_V), 0.02),
        'b_w_out': nrm((N_B_LAYERS, D, D), D ** -0.5),
        'ffn_w_up': nrm((DEPTH, D, 2 * D_FF), D ** -0.5),
        'ffn_conv_w': nrm((DEPTH, CONV_W, D_FF), CONV_W ** -0.5),
        'ffn_conv_b': nrm((DEPTH, D_FF), 0.02),
        'ffn_w_down': nrm((DEPTH, D_FF, D), D_FF ** -0.5),
    }


def reference(x_prompt, x_sample, mem_prompt, cache_mem_k, cache_mem_v, state_rwkv, state_shift,
              state_hgrn, state_conv, norm_mix, norm_ffn, norm_final, mem_norm, w_mem_kv,
              a_w_in, a_mu, a_w0, a_w2, a_a0, a_a2, a_g2, a_k_k, a_k_a, a_r_k, a_ln_w, a_ln_b, a_w_out,
              b_w_in, b_lower_bounds, b_g_norm, b_w_out, ffn_w_up, ffn_conv_w, ffn_conv_b, ffn_w_down):
    P = dict(norm_mix=norm_mix, norm_ffn=norm_ffn, norm_final=norm_final,
             a_w_in=a_w_in, a_mu=a_mu, a_w0=a_w0, a_w2=a_w2, a_a0=a_a0, a_a2=a_a2, a_g2=a_g2,
             a_k_k=a_k_k, a_k_a=a_k_a, a_r_k=a_r_k, a_ln_w=a_ln_w, a_ln_b=a_ln_b, a_w_out=a_w_out,
             b_w_in=b_w_in, b_lower_bounds=b_lower_bounds, b_g_norm=b_g_norm, b_w_out=b_w_out,
             ffn_w_up=ffn_w_up, ffn_conv_w=ffn_conv_w, ffn_conv_b=ffn_conv_b, ffn_w_down=ffn_w_down)
    bp = x_prompt.shape[0]
    dt = x_prompt.dtype
    mem_h = rmsnorm(mem_prompt[None], mem_norm[:, None, None, :])
    mem_kv = jnp.einsum('lbmd,ldk->lbmk', mem_h, w_mem_kv)
    mem_k_prompt = mem_kv[..., :MEM_WIDTH].reshape(DEPTH, bp, N_MEM, MEM_HEADS, MEM_HEAD_DIM)
    mem_v_prompt = mem_kv[..., MEM_WIDTH:].reshape(DEPTH, bp, N_MEM, MEM_HEADS, MEM_HEAD_DIM)
    y_prompt, rwkv_prompt, shift_prompt, hgrn_prompt, conv_prompt = trunk(
        x_prompt, mem_k_prompt, mem_v_prompt,
        jnp.zeros((N_A_LAYERS, bp, A_HEADS, A_HEAD_DIM, A_HEAD_DIM), dt),
        jnp.zeros((N_A_LAYERS, bp, D_MODEL), dt),
        jnp.zeros((N_B_LAYERS, bp, B_HEADS, B_EXPAND, B_HEAD_V), dt),
        jnp.zeros((DEPTH, bp, CONV_W - 1, D_FF), dt), P)
    y_sample, rwkv_sample, shift_sample, hgrn_sample, conv_sample = trunk(
        x_sample, cache_mem_k, cache_mem_v, state_rwkv, state_shift, state_hgrn, state_conv, P)
    return (y_prompt, y_sample, mem_k_prompt, mem_v_prompt, rwkv_prompt, rwkv_sample,
            shift_prompt, shift_sample, hgrn_prompt, hgrn_sample, conv_prompt, conv_sample)
```

```cpp
#include <hip/hip_runtime.h>
#include <hip/hip_bf16.h>
#include <hip/hip_cooperative_groups.h>
#include <cstdio>
namespace cg = cooperative_groups;

typedef unsigned short u16;
using bf16x8 = __attribute__((ext_vector_type(8))) short;
using f32x4 = __attribute__((ext_vector_type(4))) float;
using u16x4 = __attribute__((ext_vector_type(4))) unsigned short;

#define NTHREADS 512
#define SHM_BYTES 147456

constexpr int D = 2048, MP = 8192, MS = 1024, MT = 9216, SEQ = 2048;
constexpr int TOKW = 1536, MEMW = 512, NMEM = 256;
constexpr int APROJ = 5056, AIN_N = 5568, AIN_NP = 5632, BIN_N = 6656;
constexpr int DFF = 5632, DFF2 = 11264;
constexpr int MA0 = 9472;
constexpr int LORA_K = 512, LORA_N = 4608;

constexpr long O_YP = 0, O_YS = 16777216, O_MK = 18874368, O_MV = 19922944, O_RP = 20971520, O_RS = 21364736,
               O_SP = 33947648, O_SS = 33955840, O_HP = 34217984, O_HS = 35004416, O_CP = 60170240, O_CS = 60260352;

constexpr size_t WS_AIN = 0;
constexpr size_t WS_BIN = WS_AIN + (size_t)AIN_NP * D * 2;
constexpr size_t WS_AOUT = WS_BIN + (size_t)BIN_N * D * 2;
constexpr size_t WS_BOUT = WS_AOUT + (size_t)D * D * 2;
constexpr size_t WS_UP = WS_BOUT + (size_t)D * D * 2;
constexpr size_t WS_DN = WS_UP + (size_t)2 * DFF2 * D * 2;
constexpr size_t WS_KV = WS_DN + (size_t)2 * D * DFF * 2;
constexpr size_t WS_LORA = WS_KV + (size_t)2 * 1024 * D * 2;
constexpr size_t WS_H = WS_LORA + (size_t)LORA_N * LORA_K * 2;
constexpr size_t WS_MH = WS_H + (size_t)MA0 * D * 2;
constexpr size_t WS_P = WS_MH + (size_t)2 * 1024 * D * 2;
constexpr size_t WS_X = WS_P + (size_t)MT * BIN_N * 2;
constexpr size_t WS_TM = WS_X + (size_t)MT * D * 4;
constexpr size_t WS_BIG = WS_TM + (size_t)MT * D * 2;
constexpr size_t WS_LA = WS_BIG;
constexpr size_t WS_LOD = WS_LA + (size_t)MT * LORA_K * 2;
constexpr size_t WS_LOA = WS_LOD + (size_t)MT * TOKW * 4;
constexpr size_t WS_LOG = WS_LOA + (size_t)MT * TOKW * 2;
constexpr size_t WS_SCR = WS_LOG + (size_t)MT * TOKW * 2;
constexpr size_t WS_SCK = WS_SCR + (size_t)MT * TOKW * 2;
constexpr size_t WS_SCV = WS_SCK + (size_t)MT * TOKW * 2;
constexpr size_t WS_SCKK = WS_SCV + (size_t)MT * TOKW * 2;
constexpr size_t WS_SCB = WS_SCKK + (size_t)MT * TOKW * 2;
constexpr size_t WS_BONS = WS_SCB + (size_t)MT * TOKW * 2;
constexpr size_t WS_Y = WS_BONS + (size_t)MT * 24 * 4;
constexpr size_t WS_AV = WS_BIG;
constexpr size_t WS_U = WS_AV + (size_t)MT * DFF2 * 2;
constexpr size_t WS_SS = WS_Y + (size_t)MT * TOKW * 4;
constexpr size_t WS_BAR = WS_SS + (size_t)3 * MT * 4 + 4096;
constexpr size_t WS_FLAG = WS_BAR + 16384;
constexpr size_t WS_PART = WS_FLAG + 4096;

struct Params {
  const float *x_prompt, *x_sample, *mem_prompt, *cache_k, *cache_v, *st_rwkv, *st_shift, *st_hgrn, *st_conv;
  const float *norm_mix, *norm_ffn, *norm_final, *mem_norm, *w_mem_kv, *a_w_in, *a_mu, *a_w0, *a_w2, *a_a0, *a_a2, *a_g2,
      *a_k_k, *a_k_a, *a_r_k, *a_ln_w, *a_ln_b, *a_w_out, *b_w_in, *b_lb, *b_g_norm, *b_w_out, *ffn_w_up, *ffn_conv_w,
      *ffn_conv_b, *ffn_w_down;
  float* out;
  char* ws;
};


__device__ __forceinline__ void load_params(Params& p) {
#if defined(__HIP_DEVICE_COMPILE__)
  unsigned long long kp = (unsigned long long)__builtin_amdgcn_kernarg_segment_ptr();
  asm volatile("" : "+s"(kp));
  const __attribute__((address_space(4))) unsigned long long* s4 = (const __attribute__((address_space(4))) unsigned long long*)kp;
  unsigned long long* d = (unsigned long long*)&p;
#pragma unroll
  for (int i = 0; i < (int)(sizeof(Params) / 8); ++i) d[i] = s4[i];
#endif
}
__device__ __forceinline__ int ltid(int wv) {
  int l;
  asm volatile("v_mbcnt_lo_u32_b32 %0, -1, 0\n\tv_mbcnt_hi_u32_b32 %0, -1, %0" : "=v"(l));
  return (wv << 6) | l;
}
__device__ __forceinline__ u16 f2bf(float f) {
  return __builtin_bit_cast(u16, (__bf16)f);
}
__device__ __forceinline__ float bf2f(u16 h) { return __uint_as_float(((unsigned)h) << 16); }
template <int CTRL>
__device__ __forceinline__ float dpp_add(float x) {
  int y = __builtin_amdgcn_update_dpp(0, __float_as_int(x), CTRL, 0xf, 0xf, true);
  return x + __int_as_float(y);
}
__device__ __forceinline__ float wave_sum(float v) {
  v = dpp_add<0xB1>(v);
  v = dpp_add<0x4E>(v);
  v = dpp_add<0x141>(v);
  v = dpp_add<0x140>(v);
  int iv = __float_as_int(v);
  float a = __int_as_float(__builtin_amdgcn_readlane(iv, 0));
  float b = __int_as_float(__builtin_amdgcn_readlane(iv, 16));
  float c = __int_as_float(__builtin_amdgcn_readlane(iv, 32));
  float d = __int_as_float(__builtin_amdgcn_readlane(iv, 48));
  return (a + b) + (c + d);
}

__device__ __forceinline__ float half_sum(float v) {
  v = dpp_add<0xB1>(v);
  v = dpp_add<0x4E>(v);
  v = dpp_add<0x141>(v);
  v = dpp_add<0x140>(v);
  int o = __builtin_amdgcn_ds_swizzle(__float_as_int(v), 0x401F);
  return v + __int_as_float(o);
}
__device__ __forceinline__ float bflo(unsigned u) { return __uint_as_float(u << 16); }
__device__ __forceinline__ float bfhi(unsigned u) { return __uint_as_float(u & 0xffff0000u); }
__device__ __forceinline__ unsigned pack2(float a, float b) { return (unsigned)f2bf(a) | ((unsigned)f2bf(b) << 16); }
__device__ __forceinline__ float sigmoidf_(float x) { return 1.f / (1.f + __expf(-x)); }
__device__ __forceinline__ int prev_row(int row) {
  if (row < MP) return (row & (SEQ - 1)) == 0 ? -1 : row - 1;
  int s = row - MP;
  return (s & 7) == 0 ? MT + (s >> 3) : row - 1;
}

constexpr int BM = 256, BK = 64, HALF = 128, NXCD = 8, WGM = 8, HT = HALF * BK;

__device__ __forceinline__ int lds_byte(int r, int c) {
  int st = (r >> 4) * 2 + (c >> 5), rr = r & 15, cc = c & 31, ob = rr * 64 + cc * 2;
  return st * 1024 + (ob ^ (((ob >> 9) & 1) << 5));
}
__device__ __forceinline__ void stage_rc(int b, int& R, int& C) {
  int st = b / 1024, sb = b % 1024, swz = sb ^ (((sb >> 9) & 1) << 5);
  R = (st >> 1) * 16 + swz / 64;
  C = (st & 1) * 32 + (swz % 64) / 2;
}

__device__ __forceinline__ float epi_store(const Params& p, int ph, int tglob, int row, int col, f32x4 v, f32x4 cvec, float rs) {
  char* ws = p.ws;
  const int T2 = (MA0 / BM) * (AIN_NP / BM);
  if (ph == 1 && tglob >= T2) {
    int l = (tglob - T2) >> 4;
    float* f0 = p.out + O_MK + (size_t)l * 1024 * MEMW;
    float* f1 = p.out + O_MV + (size_t)l * 1024 * MEMW;
    if (col < MEMW) *(f32x4*)(f0 + (size_t)row * MEMW + col) = v;
    else *(f32x4*)(f1 + (size_t)row * MEMW + (col - MEMW)) = v;
  } else if (ph == 1 || ph == 13 || ph == 9 || ph == 17) {
    int ld = ph == 1 ? AIN_NP : (ph == 13 ? BIN_N : DFF2);
    u16* ob = (u16*)(ws + ((ph == 9 || ph == 17) ? WS_AV : WS_P));
    if (ph != 1 && row >= MT) return 0.f;
    if (ph != 1) v *= rs;
    if (ph == 13) {
      if (col >= MEMW && col < MEMW + TOKW) {
#pragma unroll
        for (int i = 0; i < 4; ++i) v[i] = v[i] * __builtin_amdgcn_rcpf(1.f + __expf(-v[i]));
      } else if (col >= MEMW + TOKW && col < MEMW + 2 * TOKW) {
#pragma unroll
        for (int i = 0; i < 4; ++i) v[i] = __logf(cvec[i] + (1.f - cvec[i]) * __builtin_amdgcn_rcpf(1.f + __expf(-v[i])));
      }
    }
    u16x4 o;
    o[0] = f2bf(v[0]); o[1] = f2bf(v[1]); o[2] = f2bf(v[2]); o[3] = f2bf(v[3]);
    *(u16x4*)(ob + (size_t)row * ld + col) = o;
    if ((ph == 9 || ph == 17) && col < DFF) {
      int layer = ph == 9 ? 0 : 1;
      if (row < MP) {
        int t = row & (SEQ - 1), b = row >> 11;
        if (t >= SEQ - 2) *(f32x4*)(p.out + O_CP + ((size_t)((layer * 4 + b) * 2 + (t - (SEQ - 2)))) * DFF + col) = v;
      } else {
        int s = row - MP, t = s & 7, b = s >> 3;
        if (t >= 6) *(f32x4*)(p.out + O_CS + ((size_t)((layer * 128 + b) * 2 + (t - 6))) * DFF + col) = v;
      }
    }
  } else if (ph == 3) {
    int blk = col / TOKW, c = col - blk * TOKW;
    if (blk == 0) {
      f32x4 o;
#pragma unroll
      for (int i = 0; i < 4; ++i) {
        float z = cvec[i] + v[i];
        float w = -__logf(1.f + __expf(-z)) - 0.5f;
        o[i] = __expf(-__expf(w));
      }
      *(f32x4*)((float*)(ws + WS_LOD) + (size_t)row * TOKW + c) = o;
    } else if (blk == 1) {
      u16x4 o;
#pragma unroll
      for (int i = 0; i < 4; ++i) o[i] = f2bf(__builtin_amdgcn_rcpf(1.f + __expf(-(cvec[i] + v[i]))));
      *(u16x4*)((u16*)(ws + WS_LOA) + (size_t)row * TOKW + c) = o;
    } else {
      u16x4 o;
#pragma unroll
      for (int i = 0; i < 4; ++i) o[i] = f2bf(v[i]);
      *(u16x4*)((u16*)(ws + WS_LOG) + (size_t)row * TOKW + c) = o;
    }
  } else if (tglob >= 256 && ((tglob - 256) & 3)) {
    const int pi = ((ph == 7 ? 0 : (ph == 11 ? 1 : (ph == 15 ? 2 : 3))) * 32 + ((tglob - 256) >> 2)) * 3 + (((tglob - 256) & 3) - 1);
    unsigned long long pk = (unsigned long long)f2bf(v[0]) | ((unsigned long long)f2bf(v[1]) << 16) |
                            ((unsigned long long)f2bf(v[2]) << 32) | ((unsigned long long)f2bf(v[3]) << 48);
    u16* pb = (u16*)(ws + WS_PART) + (size_t)pi * 65536 + (size_t)(row & 255) * 256 + (col & 255);
    __hip_atomic_store((unsigned long long*)pb, pk, __ATOMIC_RELAXED, __HIP_MEMORY_SCOPE_AGENT);
  } else {
    float* X = (float*)(ws + WS_X);
    const float* xin;
    if (ph == 7) xin = row < MP ? p.x_prompt + (size_t)row * D : p.x_sample + (size_t)(row - MP) * D;
    else xin = X + (size_t)row * D;
    f32x4 x = *(const f32x4*)(xin + col);
    x += v;
    *(f32x4*)(X + (size_t)row * D + col) = x;
    if (ph != 19) {
      u16x4 hb;
      hb[0] = f2bf(x[0]); hb[1] = f2bf(x[1]); hb[2] = f2bf(x[2]); hb[3] = f2bf(x[3]);
      *(u16x4*)((u16*)(ws + WS_H) + (size_t)row * D + col) = hb;
    }
    return x[0] * x[0] + x[1] * x[1] + x[2] * x[2] + x[3] * x[3];
  }
  return 0.f;
}


__device__ __forceinline__ void gemm_tile(const u16* __restrict__ A, const u16* __restrict__ Bt, int M, int N, int K,
                                          int wgid, int ph, int tglob, u16* shm, int wv, int nt) {
#define SA(b, h) (shm + ((b)*2 + (h)) * HT)
#define SB(b, h) (shm + (4 + (b)*2 + (h)) * HT)
#define STAGE(P, BASE, br, kt)                                                                            \
  do {                                                                                                    \
    const u16* _g = BASE + (long)(br)*K + (long)(kt)*BK;                                                  \
    __builtin_amdgcn_global_load_lds((const unsigned*)(_g + soff0), (unsigned*)((char*)(P) + wv * 1024), 16, 0, 0);        \
    __builtin_amdgcn_global_load_lds((const unsigned*)(_g + soff1), (unsigned*)((char*)(P) + wv * 1024 + 8192), 16, 0, 0); \
  } while (0)
#define LDA(dst, b, h)                                                                                    \
  _Pragma("unroll") for (int m = 0; m < 4; ++m)                                                           \
    _Pragma("unroll") for (int k = 0; k < 2; ++k)                                                         \
  dst[m][k] = *reinterpret_cast<const bf16x8*>(abase + (((b)*2 + (h)) * 16384 + (m * 2 + k) * 1024))
#define LDB(dst, b, h)                                                                                    \
  _Pragma("unroll") for (int n = 0; n < 2; ++n)                                                           \
    _Pragma("unroll") for (int k = 0; k < 2; ++k)                                                         \
  dst[n][k] = *reinterpret_cast<const bf16x8*>(bbase + (((b)*2 + (h)) * 16384 + (n * 2 + k) * 1024))
#define MMA(ai, bj, At, Bt_)                                                                              \
  do {                                                                                                    \
    __builtin_amdgcn_s_setprio(1);                                                                        \
    _Pragma("unroll") for (int m = 0; m < 4; ++m)                                                         \
      _Pragma("unroll") for (int n = 0; n < 2; ++n)                                                       \
        _Pragma("unroll") for (int k = 0; k < 2; ++k)                                                     \
          acc[ai][bj][m][n] =                                                                             \
              __builtin_amdgcn_mfma_f32_16x16x32_bf16(Bt_[n][k], At[m][k], acc[ai][bj][m][n], 0, 0, 0);   \
    __builtin_amdgcn_s_setprio(0);                                                                        \
  } while (0)
#define WAIT_V(n) asm volatile("s_waitcnt vmcnt(" #n ")" ::: "memory")
#define WAIT_L(n) asm volatile("s_waitcnt lgkmcnt(" #n ")" ::: "memory")
#define BAR __builtin_amdgcn_s_barrier()
#define SCHED __builtin_amdgcn_sched_barrier(0)

  const int tx = ltid(wv);
  unsigned soff0, soff1;
  {
    int r_, c_;
    stage_rc(tx * 16, r_, c_);
    soff0 = (unsigned)(r_ * K + c_);
    stage_rc(tx * 16 + 8192, r_, c_);
    soff1 = (unsigned)(r_ * K + c_);
  }
  int nM = M / BM, nN = N / BM, nwg = nM * nN;
  {
    int q = nwg / NXCD, r = nwg % NXCD, xcd = wgid % NXCD, off = wgid / NXCD;
    wgid = (xcd < r ? xcd * (q + 1) : r * (q + 1) + (xcd - r) * q) + off;
  }
  int nig = WGM * nN, gid = wgid / nig, fm = gid * WGM, gsz = min(nM - fm, WGM);
  int pm = fm + ((wgid % nig) % gsz), pn = (wgid % nig) / gsz, brow = pm * BM, bcol = pn * BM;
  if (ph == 9 || ph == 17) brow = pm * 254 - 2;
  int wid = tx >> 6, lane = tx & 63, wr = wid >> 2, wc = wid & 3, fr = lane & 15, fq = lane >> 4;
  const int swz_ = (fr * 64 + fq * 16) ^ ((((fr * 64 + fq * 16) >> 9) & 1) << 5);
  const char* abase = (const char*)shm + swz_ + wr * 8192;
  const char* bbase = (const char*)shm + swz_ + wc * 4096 + 65536;
  f32x4 acc[2][2][4][2] = {};
  bf16x8 At[4][2], B0[2][2], B1[2][2];
  STAGE(SB(0, 0), Bt, bcol, 0); STAGE(SA(0, 0), A, brow, 0);
  STAGE(SB(0, 1), Bt, bcol + HALF, 0); STAGE(SA(0, 1), A, brow + HALF, 0);
  if (wr == 1) BAR;
  WAIT_V(4); BAR;
  STAGE(SB(1, 0), Bt, bcol, 1); STAGE(SA(1, 0), A, brow, 1); STAGE(SB(1, 1), Bt, bcol + HALF, 1);
  WAIT_V(6); BAR;
  for (int t = 0; t < nt - 2; t += 2) {
    LDB(B0, 0, 0); SCHED; LDA(At, 0, 0); STAGE(SA(1, 1), A, brow + HALF, t + 1);
    WAIT_L(8); BAR; WAIT_L(0); MMA(0, 0, At, B0); BAR; SCHED;
    LDB(B1, 0, 1); STAGE(SB(0, 0), Bt, bcol, t + 2);
    BAR; WAIT_L(0); MMA(0, 1, At, B1); BAR;
    LDA(At, 0, 1); STAGE(SA(0, 0), A, brow, t + 2);
    BAR; WAIT_L(0); MMA(1, 0, At, B0); BAR; SCHED;
    STAGE(SB(0, 1), Bt, bcol + HALF, t + 2);
    WAIT_V(6); BAR; MMA(1, 1, At, B1); BAR;
    LDB(B0, 1, 0); SCHED; LDA(At, 1, 0); STAGE(SA(0, 1), A, brow + HALF, t + 2);
    WAIT_L(8); BAR; WAIT_L(0); MMA(0, 0, At, B0); BAR; SCHED;
    LDB(B1, 1, 1); STAGE(SB(1, 0), Bt, bcol, t + 3);
    BAR; WAIT_L(0); MMA(0, 1, At, B1); BAR;
    LDA(At, 1, 1); STAGE(SA(1, 0), A, brow, t + 3);
    BAR; WAIT_L(0); MMA(1, 0, At, B0); BAR; SCHED;
    STAGE(SB(1, 1), Bt, bcol + HALF, t + 3);
    WAIT_V(6); BAR; MMA(1, 1, At, B1); BAR;
  }
  { LDB(B0, 0, 0); LDA(At, 0, 0); STAGE(SA(1, 1), A, brow + HALF, nt - 1);
    BAR; WAIT_L(0); MMA(0, 0, At, B0); BAR;
    LDB(B1, 0, 1); BAR; WAIT_L(0); MMA(0, 1, At, B1); BAR;
    LDA(At, 0, 1); WAIT_V(4); BAR; WAIT_L(0); MMA(1, 0, At, B0); MMA(1, 1, At, B1); BAR; }
  { LDB(B0, 1, 0); LDA(At, 1, 0); WAIT_V(2); BAR; WAIT_L(0); MMA(0, 0, At, B0); BAR;
    LDB(B1, 1, 1); WAIT_V(0); BAR; WAIT_L(0); MMA(0, 1, At, B1); BAR;
    LDA(At, 1, 1); BAR; WAIT_L(0); MMA(1, 0, At, B0); MMA(1, 1, At, B1); BAR; }
  if (wr == 0) BAR;
  {
    float* tl = (float*)shm;
    Params p2;
    load_params(p2);
    const int tx2 = ltid(wv);
    const int wid2 = tx2 >> 6, lane2 = tx2 & 63;
    const int wr = wid2 >> 2, wc = wid2 & 3, fr = lane2 & 15, fq = lane2 >> 4;
    const int tx = tx2;
    const bool sk_unit = (ph == 7 || ph == 11 || ph == 15 || ph == 19) && tglob >= 256;
    const bool sk_part1 = sk_unit && ((tglob - 256) & 3);
    const bool sk_part0 = sk_unit && !((tglob - 256) & 3);
    const int sk_idx = (ph == 7 ? 0 : (ph == 11 ? 1 : (ph == 15 ? 2 : 3))) * 32 + (sk_unit ? ((tglob - 256) >> 2) : 0);
    int* flagp = (int*)(p2.ws + WS_FLAG) + sk_idx;
    const u16* partp = (const u16*)(p2.ws + WS_PART) + (size_t)sk_idx * 3 * 65536;
    if (sk_part0) {
      if (tx == 0) {
        while (__hip_atomic_load(flagp, __ATOMIC_RELAXED, __HIP_MEMORY_SCOPE_AGENT) < 3) __builtin_amdgcn_s_sleep(4);
      }
      __syncthreads();
      __builtin_amdgcn_fence(__ATOMIC_ACQUIRE, "agent");
    }
    if ((ph == 9 || ph == 13 || ph == 17) && tx < 256) {
      int si = ph == 9 ? 0 : (ph == 13 ? 1 : 2);
      int row = brow + tx;
      float ssv = (row >= 0 && row < MT) ? ((const float*)(p2.ws + WS_SS))[si * MT + row] : 0.f;
      ((float*)((char*)shm + 133120 + 1024))[tx] = rsqrtf(ssv * (1.f / 2048.f) + 1e-6f);
    }
#pragma unroll
    for (int ai = 0; ai < 2; ++ai) {
      __syncthreads();
#pragma unroll
      for (int bj = 0; bj < 2; ++bj)
#pragma unroll
        for (int m = 0; m < 4; ++m)
#pragma unroll
          for (int n = 0; n < 2; ++n) {
            int r = wr * 64 + m * 16 + fr;
            int c = bj * HALF + wc * 32 + n * 16 + fq * 4;
            *(f32x4*)(tl + r * 260 + c) = acc[ai][bj][m][n];
          }
      __syncthreads();
      if ((ph == 7 || ph == 11 || ph == 15 || ph == 19) && !sk_part1) {
        float* X = (float*)(p2.ws + WS_X);
        u16* Hb = (u16*)(p2.ws + WS_H);
        f32x4 xr[16];
#pragma unroll
        for (int it = 0; it < 16; ++it) {
          int idx = tx + it * NTHREADS;
          int row = brow + ai * HALF + (idx >> 6), col = bcol + (idx & 63) * 4;
          const float* xin;
          if (ph == 7) xin = row < MP ? p2.x_prompt + (size_t)row * D : p2.x_sample + (size_t)(row - MP) * D;
          else xin = X + (size_t)row * D;
          xr[it] = *(const f32x4*)(xin + col);
          if (sk_part0) {
#pragma unroll
            for (int q = 0; q < 3; ++q) {
              u16x4 pp = *(const u16x4*)(partp + (size_t)q * 65536 + (size_t)(row & 255) * 256 + (col & 255));
              xr[it][0] += bf2f(pp[0]); xr[it][1] += bf2f(pp[1]); xr[it][2] += bf2f(pp[2]); xr[it][3] += bf2f(pp[3]);
            }
          }
        }
#pragma unroll
        for (int it = 0; it < 16; ++it) {
          int idx = tx + it * NTHREADS;
          int r = idx >> 6, c4 = idx & 63;
          int row = brow + ai * HALF + r, col = bcol + c4 * 4;
          f32x4 x = xr[it] + *(const f32x4*)(tl + r * 260 + c4 * 4);
          *(f32x4*)(X + (size_t)row * D + col) = x;
          if (ph != 19) {
            u16x4 hb;
            hb[0] = f2bf(x[0]); hb[1] = f2bf(x[1]); hb[2] = f2bf(x[2]); hb[3] = f2bf(x[3]);
            *(u16x4*)(Hb + (size_t)row * D + col) = hb;
            float s = wave_sum(x[0] * x[0] + x[1] * x[1] + x[2] * x[2] + x[3] * x[3]);
            if ((tx & 63) == 0) ((float*)((char*)shm + 133120))[ai * HALF + r] = s;
          }
        }
      } else if (ph == 9 || ph == 17) {
        const int layer = ph == 9 ? 0 : 1;
        const int c4 = tx & 31, rb = tx >> 5;
        const int ch = (bcol >> 8) * 128 + c4 * 4;
        const float* cw = p2.ffn_conv_w + (size_t)layer * 3 * DFF;
        const f32x4 w0 = *(const f32x4*)(cw + ch), w1 = *(const f32x4*)(cw + DFF + ch), w2 = *(const f32x4*)(cw + 2 * DFF + ch);
        const f32x4 bb = *(const f32x4*)(p2.ffn_conv_b + (size_t)layer * DFF + ch);
        const float* rsb = (const float*)((char*)shm + 133120 + 1024);
        float* halo = (float*)((char*)shm + 133120 + 2048);
        u16* U = (u16*)(p2.ws + WS_U);
#pragma unroll 1
        for (int it = 0; it < 8; ++it) {
          const int r = rb + it * 16, tr = ai * HALF + r, grow = brow + tr;
          f32x4 a0 = *(const f32x4*)(tl + r * 260 + c4 * 4) * rsb[tr];
          f32x4 vv = *(const f32x4*)(tl + r * 260 + 128 + c4 * 4) * rsb[tr];
          f32x4 am1, am2;
          if (r >= 1) am1 = *(const f32x4*)(tl + (r - 1) * 260 + c4 * 4) * rsb[tr - 1];
          else am1 = *(const f32x4*)(halo + 128 + c4 * 4);
          if (r >= 2) am2 = *(const f32x4*)(tl + (r - 2) * 260 + c4 * 4) * rsb[tr - 2];
          else am2 = *(const f32x4*)(halo + r * 128 + c4 * 4);
          if (ai == 0 && r >= 126) *(f32x4*)(halo + (r - 126) * 128 + c4 * 4) = a0;
          if (tr >= 2 && grow < MT) {
            int t, b; const bool smp = grow >= MP;
            if (!smp) { t = grow & (SEQ - 1); b = grow >> 11; } else { int s = grow - MP; t = s & 7; b = s >> 3; }
            if (t < 2) {
              const float* sc = p2.st_conv + ((size_t)(layer * 128 + b) * 2) * DFF + ch;
              f32x4 z = {0.f, 0.f, 0.f, 0.f};
              if (t == 0) { am1 = smp ? *(const f32x4*)(sc + DFF) : z; am2 = smp ? *(const f32x4*)(sc) : z; }
              else { am2 = smp ? *(const f32x4*)(sc + DFF) : z; }
            }
            u16x4 ob;
#pragma unroll
            for (int j = 0; j < 4; ++j) {
              float cv = bb[j] + am2[j] * w0[j] + am1[j] * w1[j] + a0[j] * w2[j];
              float u2 = 1.5957691216057308f * (cv + 0.044715f * cv * cv * cv);
              float g = cv * __builtin_amdgcn_rcpf(1.f + __expf(-u2));
              ob[j] = f2bf(g * vv[j]);
            }
            *(u16x4*)(U + (size_t)grow * DFF + ch) = ob;
            const int Tn = smp ? 8 : SEQ;
            if (t >= Tn - 2) {
              float* co = smp ? p2.out + O_CS + ((size_t)(layer * 128 + b) * 2 + (t - 6)) * DFF + ch
                              : p2.out + O_CP + ((size_t)(layer * 4 + b) * 2 + (t - (SEQ - 2))) * DFF + ch;
              *(f32x4*)co = a0;
            }
          }
        }
      } else {
        const int c4 = tx & 63, rb = tx >> 6;
        const int col = bcol + c4 * 4;
        f32x4 cvec = {0.f, 0.f, 0.f, 0.f};
        if (ph == 3) {
          int blk = col / TOKW, c = col - blk * TOKW;
          if (blk == 0) cvec = *(const f32x4*)(p2.a_w0 + c);
          else if (blk == 1) cvec = *(const f32x4*)(p2.a_a0 + c);
        } else if (ph == 13 && col >= MEMW + TOKW && col < MEMW + 2 * TOKW) {
          const int cc = col - (MEMW + TOKW);
#pragma unroll
          for (int i = 0; i < 4; ++i) cvec[i] = __builtin_amdgcn_rcpf(1.f + __expf(p2.b_lb[cc + i] - p2.b_lb[TOKW + cc + i]));
        }
        const float* rsb = (const float*)((char*)shm + 133120 + 1024);
        const bool fused = (ph == 9 || ph == 13 || ph == 17);
#pragma unroll 1
        for (int it = 0; it < 16; ++it) {
          int r = rb + it * 8;
          f32x4 v = *(const f32x4*)(tl + r * 260 + c4 * 4);
          float rs = fused ? rsb[ai * HALF + r] : 1.f;
          epi_store(p2, ph, tglob, brow + ai * HALF + r, col, v, cvec, rs);
        }
      }
    }
    __syncthreads();
    if (sk_part1) {
      asm volatile("s_waitcnt vmcnt(0)" ::: "memory");
      __syncthreads();
      if (tx == 0) __hip_atomic_fetch_add(flagp, 1, __ATOMIC_RELAXED, __HIP_MEMORY_SCOPE_AGENT);
    }
    if ((ph == 7 || ph == 11 || ph == 15) && !sk_part1 && tx < 256) {
      int si = ph == 7 ? 0 : (ph == 11 ? 1 : 2);
      unsafeAtomicAdd((float*)(p2.ws + WS_SS) + si * MT + brow + tx, ((const float*)((char*)shm + 133120))[tx]);
    }
    __syncthreads();
  }
  WAIT_V(0);
#undef SA
#undef SB
#undef STAGE
#undef LDA
#undef LDB
#undef MMA
}

__device__ __forceinline__ void transpose_job(const float* __restrict__ src, int K, int N, int Npad, u16* __restrict__ dst, float* tile,
                              int start, int stride, int wv, const float* __restrict__ gain = nullptr, int perm = 0) {
  const int nk = K / 64, nn = Npad / 256, nt = nk * nn;
  const int tid = ltid(wv);
  const int kr = tid >> 6, nc = (tid & 63) * 4;
  for (int t = start; t < nt; t += stride) {
    const int tn = t % nn, tk = t / nn;
    const int k0 = tk * 64, n0 = tn * 256;
    f32x4 v[8];
#pragma unroll
    for (int h = 0; h < 8; ++h) {
      const int k = kr + h * 8;
      v[h] = (f32x4){0.f, 0.f, 0.f, 0.f};
      if (n0 + nc < N) v[h] = *(const f32x4*)(src + (size_t)(k0 + k) * N + n0 + nc);
    }
#pragma unroll
    for (int h = 0; h < 8; ++h) {
      const int k = kr + h * 8;
      if (gain) v[h] *= gain[k0 + k];
      *(f32x4*)(tile + k * 260 + nc) = v[h];
    }
    __syncthreads();
    const int n = tid >> 1, kh = (tid & 1) * 32;
    int ng = n0 + n;
    if (perm) {
      int part = ng >= DFF ? 1 : 0, m = ng - part * DFF;
      ng = (m >> 7) * 256 + part * 128 + (m & 127);
    }
    u16* dp = dst + (size_t)ng * K + k0 + kh;
#pragma unroll
    for (int q = 0; q < 4; ++q) {
      bf16x8 o;
#pragma unroll
      for (int i = 0; i < 8; ++i) o[i] = (short)f2bf(tile[(kh + q * 8 + i) * 260 + n]);
      *(bf16x8*)(dp + q * 8) = o;
    }
    __syncthreads();
  }
}

__device__ __forceinline__ void norm_row_wave(const float* __restrict__ src, const float* __restrict__ g,
                                              u16* __restrict__ dst, float* __restrict__ dstf, int lane) {
  f32x4 v[8];
  float ss = 0.f;
#pragma unroll
  for (int i = 0; i < 8; ++i) {
    v[i] = ((const f32x4*)src)[lane + 64 * i];
    ss += v[i][0] * v[i][0] + v[i][1] * v[i][1] + v[i][2] * v[i][2] + v[i][3] * v[i][3];
  }
  ss = wave_sum(ss);
  float sc = rsqrtf(ss * (1.f / 2048.f) + 1e-6f);
#pragma unroll
  for (int i = 0; i < 8; ++i) {
    f32x4 gg = ((const f32x4*)g)[lane + 64 * i];
    f32x4 o = v[i] * sc * gg;
    if (dst) {
      u16x4 ob;
      ob[0] = f2bf(o[0]); ob[1] = f2bf(o[1]); ob[2] = f2bf(o[2]); ob[3] = f2bf(o[3]);
      ((u16x4*)dst)[lane + 64 * i] = ob;
    }
    if (dstf) ((f32x4*)dstf)[lane + 64 * i] = o;
  }
}

__device__ __forceinline__ void norm_tokens(const float* xp, const float* xs, const float* g, u16* H, float* outp, float* outs, int wv) {
  const int tx = ltid(wv);
  int gw = blockIdx.x * 8 + (tx >> 6), nw = gridDim.x * 8, lane = tx & 63;
  for (int row = gw; row < MT; row += nw) {
    const float* src = row < MP ? xp + (size_t)row * D : xs + (size_t)(row - MP) * D;
    float* df = nullptr;
    if (outp) df = row < MP ? outp + (size_t)row * D : outs + (size_t)(row - MP) * D;
    norm_row_wave(src, g, H ? H + (size_t)row * D : nullptr, df, lane);
  }
}

__device__ __forceinline__ void attn_item(const u16* __restrict__ q, int ldq, int nq, const float* __restrict__ kb,
                          const float* __restrict__ vb, u16* __restrict__ o, int ldo, char* shm, int wv) {
  u16* Ks = (u16*)shm;
  u16* Vt = (u16*)(shm + 256 * 272);
  int tid = ltid(wv);
  __syncthreads();
#pragma unroll 4
  for (int i = 0; i < 16; ++i) {
    int idx = tid + 512 * i;
    int key = idx >> 5, d4 = idx & 31;
    f32x4 v = *(const f32x4*)(kb + (size_t)key * 512 + d4 * 4);
    u16x4 ob;
    ob[0] = f2bf(v[0]); ob[1] = f2bf(v[1]); ob[2] = f2bf(v[2]); ob[3] = f2bf(v[3]);
    *(u16x4*)(Ks + key * 136 + d4 * 4) = ob;
  }
#pragma unroll 2
  for (int i = 0; i < 8; ++i) {
    int idx = tid + 512 * i;
    int kp = idx >> 5, d4 = idx & 31;
    f32x4 v0 = *(const f32x4*)(vb + (size_t)(2 * kp) * 512 + d4 * 4);
    f32x4 v1 = *(const f32x4*)(vb + (size_t)(2 * kp + 1) * 512 + d4 * 4);
#pragma unroll
    for (int j = 0; j < 4; ++j) {
      unsigned pk = (unsigned)f2bf(v0[j]) | ((unsigned)f2bf(v1[j]) << 16);
      *(unsigned*)(Vt + (d4 * 4 + j) * 264 + 2 * kp) = pk;
    }
  }
  __syncthreads();
  int wid = tid >> 6, lane = tid & 63, fr = lane & 15, fq = lane >> 4;
  for (int q0 = wid * 16; q0 < nq; q0 += 128) {
    int qr = min(q0 + fr, nq - 1);
    bf16x8 qf[4];
#pragma unroll
    for (int ks = 0; ks < 4; ++ks) qf[ks] = *(const bf16x8*)(q + (size_t)qr * ldq + ks * 32 + fq * 8);
    f32x4 st[16];
#pragma unroll
    for (int kt = 0; kt < 16; ++kt) {
      f32x4 a = {0.f, 0.f, 0.f, 0.f};
#pragma unroll
      for (int ks = 0; ks < 4; ++ks) {
        bf16x8 kf = *(const bf16x8*)(Ks + (kt * 16 + fr) * 136 + ks * 32 + fq * 8);
        a = __builtin_amdgcn_mfma_f32_16x16x32_bf16(kf, qf[ks], a, 0, 0, 0);
      }
      st[kt] = a;
      __builtin_amdgcn_sched_barrier(0);
    }
    const float scale = 0.08838834764831845f;
    float mx = -1e30f;
#pragma unroll
    for (int kt = 0; kt < 16; ++kt)
#pragma unroll
      for (int j = 0; j < 4; ++j) mx = fmaxf(mx, st[kt][j]);
    mx = fmaxf(mx, __int_as_float(__builtin_amdgcn_ds_bpermute((lane ^ 16) << 2, __float_as_int(mx))));
    mx = fmaxf(mx, __int_as_float(__builtin_amdgcn_ds_bpermute((lane ^ 32) << 2, __float_as_int(mx))));
    float sum = 0.f;
#pragma unroll
    for (int kt = 0; kt < 16; ++kt)
#pragma unroll
      for (int j = 0; j < 4; ++j) {
        float pv = __expf((st[kt][j] - mx) * scale);
        st[kt][j] = pv;
        sum += pv;
      }
    sum += __int_as_float(__builtin_amdgcn_ds_bpermute((lane ^ 16) << 2, __float_as_int(sum)));
    sum += __int_as_float(__builtin_amdgcn_ds_bpermute((lane ^ 32) << 2, __float_as_int(sum)));
    float inv = 1.f / sum;
    f32x4 oa[8];
#pragma unroll
    for (int dt = 0; dt < 8; ++dt) oa[dt] = (f32x4){0.f, 0.f, 0.f, 0.f};
#pragma unroll
    for (int sl = 0; sl < 8; ++sl) {
      bf16x8 pb;
#pragma unroll
      for (int j = 0; j < 4; ++j) {
        pb[j] = (short)f2bf(st[2 * sl][j]);
        pb[4 + j] = (short)f2bf(st[2 * sl + 1][j]);
      }
#pragma unroll
      for (int dt = 0; dt < 8; ++dt) {
        const u16* vp = Vt + (dt * 16 + fr) * 264 + sl * 32 + fq * 4;
        u16x4 a0 = *(const u16x4*)vp;
        u16x4 a1 = *(const u16x4*)(vp + 16);
        bf16x8 va;
        va[0] = a0[0]; va[1] = a0[1]; va[2] = a0[2]; va[3] = a0[3];
        va[4] = a1[0]; va[5] = a1[1]; va[6] = a1[2]; va[7] = a1[3];
        oa[dt] = __builtin_amdgcn_mfma_f32_16x16x32_bf16(va, pb, oa[dt], 0, 0, 0);
      }
      __builtin_amdgcn_sched_barrier(0);
    }
    if (q0 + fr < nq) {
#pragma unroll
      for (int dt = 0; dt < 8; ++dt) {
        u16x4 ob;
#pragma unroll
        for (int j = 0; j < 4; ++j) ob[j] = f2bf(oa[dt][j] * inv);
        *(u16x4*)(o + (size_t)(q0 + fr) * ldo + dt * 16 + fq * 4) = ob;
      }
    }
  }
}

__device__ __forceinline__ void attn_phase(const Params& p, int layer, int ldp, char* shm, int wv, int start, int stride) {
  const u16* P = (const u16*)(p.ws + WS_P);
  u16* TM = (u16*)(p.ws + WS_TM);
  for (int it = start; it < 256 + 512; it += stride) {
    if (it < 256) {
      int ch = it & 15, h = (it >> 4) & 3, b = it >> 6;
      int row0 = b * SEQ + ch * 128;
      const float* kb = p.out + O_MK + ((size_t)(layer * 4 + b) * NMEM * 4 + h) * 128;
      const float* vb = p.out + O_MV + ((size_t)(layer * 4 + b) * NMEM * 4 + h) * 128;
      attn_item(P + (size_t)row0 * ldp + h * 128, ldp, 128, kb, vb, TM + (size_t)row0 * D + TOKW + h * 128, D, shm, wv);
    } else {
      int s = it - 256, h = s & 3, b = s >> 2;
      int row0 = MP + b * 8;
      const float* kb = p.cache_k + ((size_t)(layer * 128 + b) * NMEM * 4 + h) * 128;
      const float* vb = p.cache_v + ((size_t)(layer * 128 + b) * NMEM * 4 + h) * 128;
      attn_item(P + (size_t)row0 * ldp + h * 128, ldp, 8, kb, vb, TM + (size_t)row0 * D + TOKW + h * 128, D, shm, wv);
    }
  }
}

__device__ __forceinline__ float red8(float x) {
  x = dpp_add<0xB1>(x);
  x = dpp_add<0x4E>(x);
  x = dpp_add<0x141>(x);
  return x;
}

__device__ __forceinline__ void rwkv_scan_unit(const Params& p, int chain, int rg, bool sample, float* L, int lane) {
  const u16* SR = (const u16*)(p.ws + WS_SCR);
  const u16* SK = (const u16*)(p.ws + WS_SCK);
  const u16* SV = (const u16*)(p.ws + WS_SCV);
  const u16* SKK = (const u16*)(p.ws + WS_SCKK);
  const u16* SB_ = (const u16*)(p.ws + WS_SCB);
  const float* SD = (const float*)(p.ws + WS_LOD);
  float* Y = (float*)(p.ws + WS_Y);
  int b = chain / 24, h = chain - b * 24;
  int row0, T;
  if (sample) { row0 = MP + b * 8; T = 8; } else { row0 = b * SEQ; T = SEQ; }
  const int rl = lane >> 3, kq = lane & 7, row = rg * 8 + rl;
  float S[8];
  if (sample) {
    const float* sp = p.st_rwkv + (((size_t)(b * 24 + h) * 64 + row) * 64 + kq * 8);
    f32x4 s0 = *(const f32x4*)sp, s1 = *(const f32x4*)(sp + 4);
    S[0] = s0[0]; S[1] = s0[1]; S[2] = s0[2]; S[3] = s0[3];
    S[4] = s1[0]; S[5] = s1[1]; S[6] = s1[2]; S[7] = s1[3];
  } else {
#pragma unroll
    for (int i = 0; i < 8; ++i) S[i] = 0.f;
  }
  const size_t hb = (size_t)h * 64;
  const int ss = lane >> 3, cg = (lane & 7) * 8;
  bf16x8 gr0, gk0, gkk0, gb0, gr1, gk1, gkk1, gb1, gr2, gk2, gkk2, gb2;
  f32x4 gda0, gdb0, gda1, gdb1, gda2, gdb2;
  u16 gv0, gv1, gv2;
#define LOADCH(n, t0)                                                                \
  {                                                                                  \
    size_t base = (size_t)(row0 + (t0) + ss) * TOKW + hb + cg;                       \
    gr##n = *(const bf16x8*)(SR + base);                                             \
    gk##n = *(const bf16x8*)(SK + base);                                             \
    gkk##n = *(const bf16x8*)(SKK + base);                                           \
    gb##n = *(const bf16x8*)(SB_ + base);                                            \
    size_t bd = (size_t)(row0 + (t0) + (lane >> 4)) * TOKW + hb + (lane & 15) * 4;   \
    gda##n = *(const f32x4*)(SD + bd);                                               \
    gdb##n = *(const f32x4*)(SD + bd + (size_t)4 * TOKW);                            \
    gv##n = SV[(size_t)(row0 + (t0) + ss) * TOKW + hb + rg * 8 + (lane & 7)];        \
  }
#define ST8(arr, a)                                                                  \
  {                                                                                  \
    f32x4 lo, hi;                                                                    \
    lo[0] = bf2f((u16)arr[0]); lo[1] = bf2f((u16)arr[1]); lo[2] = bf2f((u16)arr[2]); lo[3] = bf2f((u16)arr[3]); \
    hi[0] = bf2f((u16)arr[4]); hi[1] = bf2f((u16)arr[5]); hi[2] = bf2f((u16)arr[6]); hi[3] = bf2f((u16)arr[7]); \
    *(f32x4*)(L + ss * 328 + (a)*64 + cg) = lo;                                      \
    *(f32x4*)(L + ss * 328 + (a)*64 + cg + 4) = hi;                                  \
  }
#define LDSTEP(dst, s)                                                               \
  {                                                                                  \
    const float* Ls = L + (s)*328 + kq * 8;                                          \
    dst[4] = *(const f32x4*)(Ls + 128);                                              \
    dst[5] = *(const f32x4*)(Ls + 132);                                              \
    dst[8] = *(const f32x4*)(Ls + 256);                                              \
    dst[9] = *(const f32x4*)(Ls + 260);                                              \
    dst##v = L[(s)*328 + 320 + rl];                                                  \
  }
#define LDRK(dst, s)                                                                 \
  {                                                                                  \
    const float* Ls = L + (s)*328 + kq * 8;                                          \
    dst[0] = *(const f32x4*)(Ls);                                                    \
    dst[1] = *(const f32x4*)(Ls + 4);                                                \
    dst[2] = *(const f32x4*)(Ls + 64);                                               \
    dst[3] = *(const f32x4*)(Ls + 68);                                               \
    dst[4] = *(const f32x4*)(Ls + 192);                                              \
    dst[5] = *(const f32x4*)(Ls + 196);                                              \
  }
#define STEP(cur, s)                                                                 \
  {                                                                                  \
    LDRK(RK, s);                                                                     \
    float sa = 0.f;                                                                  \
    _Pragma("unroll") for (int i = 0; i < 4; ++i) sa += S[i] * cur[4][i] + S[4 + i] * cur[5][i]; \
    sa = red8(sa);                                                                   \
    float v = cur##v;                                                                \
    float y = 0.f;                                                                   \
    _Pragma("unroll") for (int i = 0; i < 4; ++i) {                                  \
      S[i] = S[i] * cur[8][i] - sa * RK[4][i] + v * RK[2][i];                       \
      S[4 + i] = S[4 + i] * cur[9][i] - sa * RK[5][i] + v * RK[3][i];               \
      y += S[i] * RK[0][i] + S[4 + i] * RK[1][i];                                    \
    }                                                                                \
    ys[s] = red8(y);                                                                 \
  }
#define CHUNK(n, t0)                                                   \
  {                                                                    \
    ST8(gr##n, 0); ST8(gk##n, 1); ST8(gkk##n, 2); ST8(gb##n, 3); \
    *(f32x4*)(L + (lane >> 4) * 328 + 256 + (lane & 15) * 4) = gda##n; \
    *(f32x4*)(L + ((lane >> 4) + 4) * 328 + 256 + (lane & 15) * 4) = gdb##n; \
    L[ss * 328 + 320 + (lane & 7)] = bf2f(gv##n); \
    __builtin_amdgcn_wave_barrier(); \
    if (t0 + 16 < T) { LOADCH(n, t0 + 16); } \
    f32x4 A[10], B[10], RK[6]; \
    float Av, Bv; \
    float ys[8]; \
    __builtin_amdgcn_sched_barrier(0); LDSTEP(A, 0); \
    LDSTEP(B, 1); STEP(A, 0); __builtin_amdgcn_sched_barrier(0); \
    LDSTEP(A, 2); STEP(B, 1); __builtin_amdgcn_sched_barrier(0); \
    LDSTEP(B, 3); STEP(A, 2); __builtin_amdgcn_sched_barrier(0); \
    LDSTEP(A, 4); STEP(B, 3); __builtin_amdgcn_sched_barrier(0); \
    LDSTEP(B, 5); STEP(A, 4); __builtin_amdgcn_sched_barrier(0); \
    LDSTEP(A, 6); STEP(B, 5); __builtin_amdgcn_sched_barrier(0); \
    LDSTEP(B, 7); STEP(A, 6); __builtin_amdgcn_sched_barrier(0); \
    STEP(B, 7); \
    float yo = ys[0]; \
    _Pragma("unroll") for (int s = 1; s < 8; ++s) yo = (kq == s) ? ys[s] : yo; \
    Y[(size_t)(row0 + t0 + kq) * TOKW + hb + row] = yo; \
    __builtin_amdgcn_wave_barrier(); \
  }
  LOADCH(0, 0);
  if (T > 8) { LOADCH(1, 8); }
  for (int tb = 0; tb < T; tb += 16) {
    { const int t0 = tb; CHUNK(0, t0) }
    if (tb + 8 < T) { const int t0 = tb + 8; CHUNK(1, t0) }
  }
#undef CHUNK
#undef LOADCH
#undef ST8
#undef LDSTEP
#undef LDRK
#undef STEP
  float* so = (sample ? p.out + O_RS : p.out + O_RP) + (((size_t)(b * 24 + h) * 64 + row) * 64 + kq * 8);
  *(f32x4*)so = (f32x4){S[0], S[1], S[2], S[3]};
  *(f32x4*)(so + 4) = (f32x4){S[4], S[5], S[6], S[7]};
}

__device__ __forceinline__ void hgrn_seq(const Params& p, int b, int h, bool sample, char* shm, int wv) {
  const u16* P = (const u16*)(p.ws + WS_P);
  float* O = (float*)(p.ws + WS_Y);
  float* lq = (float*)shm;
  float* lf = lq + 1024;
  float* li = lf + 1024;
  float* part = li + 1024;
  int tid = ltid(wv), v = tid & 127, kq = tid >> 7;
  int row0, T;
  if (sample) { row0 = MP + b * 8; T = 8; } else { row0 = b * SEQ; T = SEQ; }
  float S[32];
  if (sample) {
    const float* sp = p.st_hgrn + ((size_t)(b * 12 + h) * 128 + kq * 32) * 128 + v;
#pragma unroll
    for (int i = 0; i < 32; ++i) S[i] = sp[(size_t)i * 128];
  } else {
#pragma unroll
    for (int i = 0; i < 32; ++i) S[i] = 0.f;
  }
  for (int t0 = 0; t0 < T; t0 += 8) {
    __syncthreads();
#pragma unroll
    for (int e = 0; e < 6; ++e) {
      int idx = tid + 512 * e;
      int arr = idx >> 10, s = (idx >> 7) & 7, c = idx & 127;
      float val = bf2f(P[(size_t)(row0 + t0 + s) * BIN_N + MEMW + arr * TOKW + h * 128 + c]);
      if (arr == 1) val = __expf(val);
      lq[idx] = val;
    }
    __syncthreads();
#pragma unroll 1
    for (int s = 0; s < 8; ++s) {
      float vv = li[s * 128 + v];
      float o = 0.f;
      const float* fq_ = lf + s * 128 + kq * 32;
      const float* qq_ = lq + s * 128 + kq * 32;
#pragma unroll
      for (int i4 = 0; i4 < 8; ++i4) {
        f32x4 f4 = *(const f32x4*)(fq_ + i4 * 4);
        f32x4 q4 = *(const f32x4*)(qq_ + i4 * 4);
#pragma unroll
        for (int j = 0; j < 4; ++j) {
          float f = f4[j];
          float sn = f * S[i4 * 4 + j] + (1.f - f) * vv;
          S[i4 * 4 + j] = sn;
          o += q4[j] * sn;
        }
      }
      part[(kq * 8 + s) * 128 + v] = o;
    }
    __syncthreads();
#pragma unroll
    for (int e = 0; e < 2; ++e) {
      int idx = tid + 512 * e;
      int s = idx >> 7, c = idx & 127;
      float o = part[idx] + part[1024 + idx] + part[2048 + idx] + part[3072 + idx];
      O[(size_t)(row0 + t0 + s) * TOKW + h * 128 + c] = o;
    }
  }
  float* so = (sample ? p.out + O_HS : p.out + O_HP) + ((size_t)(b * 12 + h) * 128 + kq * 32) * 128 + v;
#pragma unroll
  for (int i = 0; i < 32; ++i) {
    *so = S[i];
    so += 128;
    asm volatile("" : "+v"(so));
  }
}


__device__ __forceinline__ float fast_sigmoid(float x) { return __builtin_amdgcn_rcpf(1.f + __expf(-x)); }

__device__ __forceinline__ void hgrn_prompt_mfma(const Params& p, int b, int h, char* shm, int wv) {
  const u16* P = (const u16*)(p.ws + WS_P);
  float* O = (float*)(p.ws + WS_Y);
  u16* Qe = (u16*)shm;
  u16* Kd = Qe + 64 * 136;
  u16* Kdt = Kd + 64 * 136;
  u16* Vt = Kdt + 128 * 72;
  u16* Pt = Vt + 128 * 72;
  u16* St = Pt + 64 * 72;
  float* tot = (float*)(St + 128 * 136);
  float* eb = tot + 1024;
  const int tid = ltid(wv), lane = tid & 63, w = wv;
  const int fr = lane & 15, fq = lane >> 4;
  const int c0 = lane * 2;
  const int row0 = b * SEQ;
  float lb0, lb1;
  {
    int cc = h * 128 + c0;
    lb0 = 1.f / (1.f + __expf(p.b_lb[cc] - p.b_lb[TOKW + cc]));
    lb1 = 1.f / (1.f + __expf(p.b_lb[cc + 1] - p.b_lb[TOKW + cc + 1]));
  }
  unsigned rq[8], rf[8], ri[8];
#define LOADRAW(t0)                                                                        \
  _Pragma("unroll") for (int i = 0; i < 8; ++i) {                                          \
    const u16* bp = P + (size_t)(row0 + (t0) + w * 8 + i) * BIN_N + MEMW + h * 128 + c0;   \
    rq[i] = *(const unsigned*)(bp);                                                        \
    rf[i] = *(const unsigned*)(bp + TOKW);                                                 \
    ri[i] = *(const unsigned*)(bp + 2 * TOKW);                                             \
  }
  f32x4 S[8];
#pragma unroll
  for (int i = 0; i < 8; ++i) S[i] = (f32x4){0.f, 0.f, 0.f, 0.f};
  LOADRAW(0);
  __syncthreads();
#pragma unroll 1
  for (int chunk = 0; chunk < 32; ++chunk) {
    const int t0 = chunk * 64;
    float qs0[8], qs1[8], om0[8], om1[8], cs0[8], cs1[8];
    float run0 = 0.f, run1 = 0.f;
    bf16x8 v0, v1;
#pragma unroll
    for (int i = 0; i < 8; ++i) {
      float q0 = __uint_as_float(rq[i] << 16), q1 = __uint_as_float(rq[i] & 0xffff0000u);
      float f0 = __uint_as_float(rf[i] << 16), f1 = __uint_as_float(rf[i] & 0xffff0000u);
      qs0[i] = q0;
      qs1[i] = q1;
      float g0 = __expf(f0);
      float g1 = __expf(f1);
      run0 += f0; run1 += f1;
      cs0[i] = run0; cs1[i] = run1;
      om0[i] = 1.f - g0; om1[i] = 1.f - g1;
      v0[i] = (short)(ri[i] & 0xffffu);
      v1[i] = (short)(ri[i] >> 16);
    }
    tot[w * 128 + c0] = run0;
    tot[w * 128 + c0 + 1] = run1;
    *(bf16x8*)(Vt + c0 * 72 + w * 8) = v0;
    *(bf16x8*)(Vt + (c0 + 1) * 72 + w * 8) = v1;
    __syncthreads();
    float pre0 = 0.f, pre1 = 0.f, bl0 = 0.f, bl1 = 0.f;
#pragma unroll
    for (int ww = 0; ww < 8; ++ww) {
      float a0 = tot[ww * 128 + c0], a1 = tot[ww * 128 + c0 + 1];
      if (ww < w) { pre0 += a0; pre1 += a1; }
      bl0 += a0; bl1 += a1;
    }
    bf16x8 kt0, kt1;
#pragma unroll
    for (int i = 0; i < 8; ++i) {
      float bc0 = pre0 + cs0[i], bc1 = pre1 + cs1[i];
      float qe0 = qs0[i] * __expf(bc0), qe1 = qs1[i] * __expf(bc1);
      float kd0 = om0[i] * __expf(-bc0), kd1 = om1[i] * __expf(-bc1);
      u16 k0b = f2bf(kd0), k1b = f2bf(kd1);
      *(unsigned*)(Qe + (w * 8 + i) * 136 + c0) = (unsigned)f2bf(qe0) | ((unsigned)f2bf(qe1) << 16);
      *(unsigned*)(Kd + (w * 8 + i) * 136 + c0) = (unsigned)k0b | ((unsigned)k1b << 16);
      kt0[i] = (short)k0b; kt1[i] = (short)k1b;
    }
    *(bf16x8*)(Kdt + c0 * 72 + w * 8) = kt0;
    *(bf16x8*)(Kdt + (c0 + 1) * 72 + w * 8) = kt1;
    if (w == 0) { eb[c0] = __expf(bl0); eb[c0 + 1] = __expf(bl1); }
    __syncthreads();
    if (chunk + 1 < 32) { LOADRAW(t0 + 64); }
#pragma unroll
    for (int e = 0; e < 2; ++e) {
      int id = w * 2 + e, st = id >> 2, tt = id & 3;
      u16x4 outv = {0, 0, 0, 0};
      if (st <= tt) {
        f32x4 a = {0.f, 0.f, 0.f, 0.f};
#pragma unroll
        for (int ks = 0; ks < 4; ++ks) {
          bf16x8 ka = *(const bf16x8*)(Kd + (st * 16 + fr) * 136 + ks * 32 + fq * 8);
          bf16x8 qb = *(const bf16x8*)(Qe + (tt * 16 + fr) * 136 + ks * 32 + fq * 8);
          a = __builtin_amdgcn_mfma_f32_16x16x32_bf16(ka, qb, a, 0, 0, 0);
        }
#pragma unroll
        for (int j = 0; j < 4; ++j) {
          float val = a[j];
          if (st == tt && fq * 4 + j > fr) val = 0.f;
          outv[j] = f2bf(val);
        }
      }
      *(u16x4*)(Pt + (tt * 16 + fr) * 72 + st * 16 + fq * 4) = outv;
    }
    __syncthreads();
    f32x4 oa[4];
#pragma unroll
    for (int tt = 0; tt < 4; ++tt) oa[tt] = (f32x4){0.f, 0.f, 0.f, 0.f};
#pragma unroll
    for (int sl = 0; sl < 2; ++sl) {
      bf16x8 va = *(const bf16x8*)(Vt + (w * 16 + fr) * 72 + sl * 32 + fq * 8);
#pragma unroll
      for (int tt = 0; tt < 4; ++tt) {
        bf16x8 pb = *(const bf16x8*)(Pt + (tt * 16 + fr) * 72 + sl * 32 + fq * 8);
        oa[tt] = __builtin_amdgcn_mfma_f32_16x16x32_bf16(va, pb, oa[tt], 0, 0, 0);
      }
    }
    if (chunk > 0) {
#pragma unroll
      for (int ks = 0; ks < 4; ++ks) {
        bf16x8 sa = *(const bf16x8*)(St + (w * 16 + fr) * 136 + ks * 32 + fq * 8);
#pragma unroll
        for (int tt = 0; tt < 4; ++tt) {
          bf16x8 qb = *(const bf16x8*)(Qe + (tt * 16 + fr) * 136 + ks * 32 + fq * 8);
          oa[tt] = __builtin_amdgcn_mfma_f32_16x16x32_bf16(sa, qb, oa[tt], 0, 0, 0);
        }
      }
    }
#pragma unroll
    for (int tt = 0; tt < 4; ++tt)
      *(f32x4*)(O + (size_t)(row0 + t0 + tt * 16 + fr) * TOKW + h * 128 + w * 16 + fq * 4) = oa[tt];
#pragma unroll
    for (int sl = 0; sl < 2; ++sl) {
      bf16x8 ka = *(const bf16x8*)(Kdt + (w * 16 + fr) * 72 + sl * 32 + fq * 8);
#pragma unroll
      for (int vt = 0; vt < 8; ++vt) {
        bf16x8 vb = *(const bf16x8*)(Vt + (vt * 16 + fr) * 72 + sl * 32 + fq * 8);
        S[vt] = __builtin_amdgcn_mfma_f32_16x16x32_bf16(ka, vb, S[vt], 0, 0, 0);
      }
    }
    {
      f32x4 e4 = *(const f32x4*)(eb + w * 16 + fq * 4);
#pragma unroll
      for (int vt = 0; vt < 8; ++vt) S[vt] *= e4;
    }
    __syncthreads();
#pragma unroll
    for (int vt = 0; vt < 8; ++vt) {
      u16x4 o;
      o[0] = f2bf(S[vt][0]); o[1] = f2bf(S[vt][1]); o[2] = f2bf(S[vt][2]); o[3] = f2bf(S[vt][3]);
      *(u16x4*)(St + (vt * 16 + fr) * 136 + w * 16 + fq * 4) = o;
    }
  }
#undef LOADRAW
  float* so = p.out + O_HP + (size_t)(b * 12 + h) * 128 * 128;
#pragma unroll
  for (int vt = 0; vt < 8; ++vt)
#pragma unroll
    for (int j = 0; j < 4; ++j) so[(size_t)(w * 16 + fq * 4 + j) * 128 + vt * 16 + fr] = S[vt][j];
  __syncthreads();
}

__device__ __forceinline__ void gemm_phase(int ph, char* shm, int wv) {
  const int T2 = (MA0 / BM) * (AIN_NP / BM);
  int total;
  if (ph == 1) total = T2 + 32;
  else if (ph == 3) total = (MT / BM) * (LORA_N / BM);
  else if (ph == 9 || ph == 17) total = 37 * (DFF2 / BM);
  else if (ph == 13) total = (MT / BM) * (BIN_N / BM);
  else total = 256 + 128;
  for (int t = blockIdx.x; t < total; t += gridDim.x) {
    char* ws;
    {
      Params p2;
      load_params(p2);
      ws = p2.ws;
    }
    const u16* A; const u16* Bt; int M, N, K;
    int lt = t;
    int nt = 32;
    if (ph == 1) {
      if (t < T2) {
        A = (const u16*)(ws + WS_H); Bt = (const u16*)(ws + WS_AIN); M = MA0; N = AIN_NP; K = D;
      } else {
        int l = (t - T2) >> 4; lt = (t - T2) & 15;
        A = (const u16*)(ws + WS_MH) + (size_t)l * 1024 * D; Bt = (const u16*)(ws + WS_KV) + (size_t)l * 1024 * D;
        M = 1024; N = 1024; K = D;
      }
    } else if (ph == 3) {
      A = (const u16*)(ws + WS_LA); Bt = (const u16*)(ws + WS_LORA); M = MT; N = LORA_N; K = LORA_K;
      {
        const int nN_ = LORA_N / BM, nM_ = MT / BM, nwg_ = nM_ * nN_;
        int w_ = t;
        { int q = nwg_ / NXCD, r = nwg_ % NXCD, xcd = w_ % NXCD, off = w_ / NXCD; w_ = (xcd < r ? xcd * (q + 1) : r * (q + 1) + (xcd - r) * q) + off; }
        int nig_ = WGM * nN_, gid_ = w_ / nig_, fm_ = gid_ * WGM, gsz_ = min(nM_ - fm_, WGM);
        int pn_ = (w_ % nig_) / gsz_;
        int blk_ = (pn_ * BM) / TOKW;
        int kofs = blk_ == 0 ? 0 : (blk_ == 1 ? 64 : 192);
        nt = blk_ == 2 ? 4 : 2;
        A += kofs; Bt += kofs;
      }
    } else if (ph == 7 || ph == 15) {
      A = (const u16*)(ws + WS_TM); Bt = (const u16*)(ws + (ph == 7 ? WS_AOUT : WS_BOUT)); M = MT; N = D; K = D;
      if (t >= 256) { const int j = t - 256; lt = 256 + (j >> 2); nt = 8; A += (j & 3) * 8 * BK; Bt += (j & 3) * 8 * BK; }
    } else if (ph == 9 || ph == 17) {
      int layer = ph == 9 ? 0 : 1;
      A = (const u16*)(ws + WS_H); Bt = (const u16*)(ws + WS_UP) + (size_t)layer * DFF2 * D; M = 37 * BM; N = DFF2; K = D;
    } else if (ph == 11 || ph == 19) {
      int layer = ph == 11 ? 0 : 1;
      A = (const u16*)(ws + WS_U); Bt = (const u16*)(ws + WS_DN) + (size_t)layer * D * DFF; M = MT; N = D; K = DFF; nt = DFF / BK;
      if (t >= 256) { const int j = t - 256; lt = 256 + (j >> 2); nt = 22; A += (j & 3) * 22 * BK; Bt += (j & 3) * 22 * BK; }
    } else {
      A = (const u16*)(ws + WS_H); Bt = (const u16*)(ws + WS_BIN); M = MT; N = BIN_N; K = D;
    }
    gemm_tile(A, Bt, M, N, K, lt, ph, t, (u16*)shm, wv, nt);
  }
  {
    int r0 = -1;
    if (ph == 9) r0 = 92;
    else if (ph == 11) r0 = 128;
    else if (ph == 13) r0 = 168;
    if (r0 >= 0 && (int)blockIdx.x >= r0) {
      Params p2;
      load_params(p2);
      char* ws = p2.ws;
      float* tile = (float*)shm;
      const int st = blockIdx.x - r0;
      int g = (int)gridDim.x - r0;
      asm volatile("" : "+s"(g));
      __syncthreads();
      if (ph == 9) {
        transpose_job(p2.b_w_in, D, BIN_N, BIN_N, (u16*)(ws + WS_BIN), tile, st, g, wv, p2.norm_mix + D);
        transpose_job(p2.b_w_out, D, D, D, (u16*)(ws + WS_BOUT), tile, (st + 64) % g, g, wv);
        transpose_job(p2.ffn_w_down, DFF, D, D, (u16*)(ws + WS_DN), tile, (st + 100) % g, g, wv);
      } else if (ph == 11) {
        transpose_job(p2.ffn_w_up + (size_t)D * DFF2, D, DFF2, DFF2, (u16*)(ws + WS_UP) + (size_t)DFF2 * D, tile, st, g, wv, p2.norm_ffn + D, 1);
      } else {
        transpose_job(p2.ffn_w_down + (size_t)DFF * D, DFF, D, D, (u16*)(ws + WS_DN) + (size_t)D * DFF, tile, st, g, wv);
      }
    }
  }
}

constexpr int NPHASE = 17;

__device__ __forceinline__ void run_phase(const Params& p, int ph, char* shm, int wv) {
#define PH_TID const int tid = ltid(wv), lane = tid & 63, wid = tid >> 6; const int gw = blockIdx.x * 8 + wid, nw = gridDim.x * 8; (void)tid; (void)lane; (void)gw; (void)nw;
#define GTID ((size_t)blockIdx.x * NTHREADS + tid)
#define GTHREADS ((size_t)gridDim.x * NTHREADS)
  char* ws = p.ws;
  u16* H = (u16*)(ws + WS_H);
  u16* PB = (u16*)(ws + WS_P);
  float* X = (float*)(ws + WS_X);
  u16* TM = (u16*)(ws + WS_TM);
  switch (ph) {
    case 0: {
      PH_TID
      float* tile = (float*)shm;
      {
        const int g = gridDim.x, bx = blockIdx.x;
        transpose_job(p.a_w_in, D, AIN_N, AIN_NP, (u16*)(ws + WS_AIN), tile, bx, g, wv);
        transpose_job(p.w_mem_kv, D, 1024, 1024, (u16*)(ws + WS_KV), tile, (bx + 40) % g, g, wv);
        transpose_job(p.w_mem_kv + (size_t)D * 1024, D, 1024, 1024, (u16*)(ws + WS_KV) + (size_t)1024 * D, tile, (bx + 80) % g, g, wv);
        transpose_job(p.a_w_out, D, D, D, (u16*)(ws + WS_AOUT), tile, (bx + 160) % g, g, wv);
      }
      for (size_t i = GTID; i < (size_t)3 * MT; i += GTHREADS) ((float*)(ws + WS_SS))[i] = 0.f;
      for (size_t i = GTID; i < 4 * 32; i += GTHREADS) ((int*)(ws + WS_FLAG))[i] = 0;
      u16* WL = (u16*)(ws + WS_LORA);
      for (size_t i = GTID; i < (size_t)LORA_N * LORA_K; i += GTHREADS) {
        int n = (int)(i >> 9), k = (int)(i & 511);
        float v = 0.f;
        if (n < TOKW) { if (k < 96) v = p.a_w2[(size_t)k * TOKW + n]; }
        else if (n < 2 * TOKW) { if (k >= 96 && k < 192) v = p.a_a2[(size_t)(k - 96) * TOKW + (n - TOKW)]; }
        else { if (k >= 192 && k < 448) v = p.a_g2[(size_t)(k - 192) * TOKW + (n - 2 * TOKW)]; }
        WL[i] = f2bf(v);
      }
      for (int r = gw; r < MA0 + 2048; r += nw) {
        if (r < MT) {
          const float* src = r < MP ? p.x_prompt + (size_t)r * D : p.x_sample + (size_t)(r - MP) * D;
          float* df = nullptr;
          if (r < MP) { if ((r & (SEQ - 1)) == SEQ - 1) df = p.out + O_SP + (size_t)(r >> 11) * D; }
          else { int s = r - MP; if ((s & 7) == 7) df = p.out + O_SS + (size_t)(s >> 3) * D; }
          norm_row_wave(src, p.norm_mix, H + (size_t)r * D, df, lane);
        } else if (r < MT + 128) {
          const float* src = p.st_shift + (size_t)(r - MT) * D;
#pragma unroll
          for (int i = 0; i < 8; ++i) {
            f32x4 v = ((const f32x4*)src)[lane + 64 * i];
            u16x4 ob; ob[0] = f2bf(v[0]); ob[1] = f2bf(v[1]); ob[2] = f2bf(v[2]); ob[3] = f2bf(v[3]);
            ((u16x4*)(H + (size_t)r * D))[lane + 64 * i] = ob;
          }
        } else if (r < MA0) {
          u16x4 z = {0, 0, 0, 0};
#pragma unroll
          for (int i = 0; i < 8; ++i) ((u16x4*)(H + (size_t)r * D))[lane + 64 * i] = z;
        } else {
          int m = r - MA0, l = m >> 10, mr = m & 1023;
          norm_row_wave(p.mem_prompt + (size_t)mr * D, p.mem_norm + (size_t)l * D,
                        (u16*)(ws + WS_MH) + (size_t)m * D, nullptr, lane);
        }
      }
    } break;

    case 2: {
      PH_TID
      u16* LA = (u16*)(ws + WS_LA);
      for (size_t i = GTID; i < (size_t)MT * 64; i += GTHREADS) {
        const int row = (int)(i >> 6), j8 = (int)(i & 63) * 8;
        bf16x8 ob;
        if (j8 < 448) {
          const int col = MEMW + 4608 + j8;
          const bf16x8 pc = *(const bf16x8*)(PB + (size_t)row * AIN_NP + col);
          const int pr = prev_row(row);
          bf16x8 pp = {0, 0, 0, 0, 0, 0, 0, 0};
          if (pr >= 0) pp = *(const bf16x8*)(PB + (size_t)pr * AIN_NP + col);
          const f32x4 m0 = *(const f32x4*)(p.a_mu + 4608 + j8), m1 = *(const f32x4*)(p.a_mu + 4608 + j8 + 4);
#pragma unroll
          for (int e = 0; e < 8; ++e) {
            float c = bf2f((u16)pc[e]), q = bf2f((u16)pp[e]);
            float mu = e < 4 ? m0[e & 3] : m1[e & 3];
            float xm = c + mu * (q - c);
            float val;
            if (j8 < 96) val = 1.f - 2.f * __builtin_amdgcn_rcpf(1.f + __expf(2.f * xm));
            else if (j8 < 192) val = xm;
            else val = __builtin_amdgcn_rcpf(1.f + __expf(-xm));
            ob[e] = (short)f2bf(val);
          }
        } else {
          ob = (bf16x8){0, 0, 0, 0, 0, 0, 0, 0};
        }
        *(bf16x8*)(LA + (size_t)row * LORA_K + j8) = ob;
      }
    } break;

    case 4: {
      PH_TID
      const u16* LOA = (const u16*)(ws + WS_LOA);
      u16 *SR = (u16*)(ws + WS_SCR), *SK = (u16*)(ws + WS_SCK), *SV = (u16*)(ws + WS_SCV), *SKK = (u16*)(ws + WS_SCKK),
          *SBB = (u16*)(ws + WS_SCB);
      float* BONS = (float*)(ws + WS_BONS);
      const int hl = lane >> 5, l2 = (lane & 31) * 2;
      const int nseg = nw / 12, hp = gw % 12, seg = gw / 12;
      if (seg < nseg) {
        const int rps = (MT + nseg - 1) / nseg;
        const int rbeg = seg * rps, rend = min(rbeg + rps, MT);
        const int h = hp * 2 + hl, c = h * 64 + l2;
        const float2 mur = *(const float2*)(p.a_mu + c), muk = *(const float2*)(p.a_mu + TOKW + c), muv = *(const float2*)(p.a_mu + 2 * TOKW + c);
        const float2 kkw = *(const float2*)(p.a_k_k + c), kaw = *(const float2*)(p.a_k_a + c), rkw = *(const float2*)(p.a_r_k + c);
        const u16* pcb = PB + MEMW + c;
        unsigned pr_ = 0, pk_ = 0, pv_ = 0;
        unsigned nr = 0, nk = 0, nv = 0, na = 0;
        if (rbeg < rend) {
          const u16* q_ = pcb + (size_t)rbeg * AIN_NP;
          nr = *(const unsigned*)q_; nk = *(const unsigned*)(q_ + TOKW); nv = *(const unsigned*)(q_ + 2 * TOKW);
          na = *(const unsigned*)(LOA + (size_t)rbeg * TOKW + c);
          int pr = prev_row(rbeg);
          if (pr >= 0) { const u16* pp_ = pcb + (size_t)pr * AIN_NP; pr_ = *(const unsigned*)pp_; pk_ = *(const unsigned*)(pp_ + TOKW); pv_ = *(const unsigned*)(pp_ + 2 * TOKW); }
        }
        for (int row = rbeg; row < rend; ++row) {
          const unsigned ur = nr, uk = nk, uv = nv, ua = na;
          if (row + 1 < rend) {
            const u16* q_ = pcb + (size_t)(row + 1) * AIN_NP;
            nr = *(const unsigned*)q_; nk = *(const unsigned*)(q_ + TOKW); nv = *(const unsigned*)(q_ + 2 * TOKW);
            na = *(const unsigned*)(LOA + (size_t)(row + 1) * TOKW + c);
          }
          float r0 = bflo(ur), r1 = bfhi(ur), k0 = bflo(uk), k1 = bfhi(uk), v0 = bflo(uv), v1 = bfhi(uv);
          r0 += mur.x * (bflo(pr_) - r0); r1 += mur.y * (bfhi(pr_) - r1);
          k0 += muk.x * (bflo(pk_) - k0); k1 += muk.y * (bfhi(pk_) - k1);
          v0 += muv.x * (bflo(pv_) - v0); v1 += muv.y * (bfhi(pv_) - v1);
          {
            int prn = prev_row(row + 1);
            if (prn == row) { pr_ = ur; pk_ = uk; pv_ = uv; }
            else if (prn < 0) { pr_ = 0; pk_ = 0; pv_ = 0; }
            else if (row + 1 < rend) { const u16* pp_ = pcb + (size_t)prn * AIN_NP; pr_ = *(const unsigned*)pp_; pk_ = *(const unsigned*)(pp_ + TOKW); pv_ = *(const unsigned*)(pp_ + 2 * TOKW); }
          }
          float a0 = bflo(ua), a1 = bfhi(ua);
          float kk0 = k0 * kkw.x, kk1 = k1 * kkw.y;
          float ss = half_sum(kk0 * kk0 + kk1 * kk1);
          float rn = rsqrtf(fmaxf(ss, 1e-24f));
          kk0 *= rn; kk1 *= rn;
          float k20 = k0 * (1.f + (a0 - 1.f) * kaw.x), k21 = k1 * (1.f + (a1 - 1.f) * kaw.y);
          float bon = half_sum(r0 * k20 * rkw.x + r1 * k21 * rkw.y);
          size_t o = (size_t)row * TOKW + c;
          *(unsigned*)(SR + o) = pack2(r0, r1);
          *(unsigned*)(SK + o) = pack2(k20, k21);
          *(unsigned*)(SV + o) = pack2(v0, v1);
          *(unsigned*)(SKK + o) = pack2(kk0, kk1);
          *(unsigned*)(SBB + o) = pack2(kk0 * a0, kk1 * a1);
          if ((lane & 31) == 0) BONS[(size_t)row * 24 + h] = bon;
        }
      }
    } break;
    case 5: {
      PH_TID
      const int NSB = 192;
      const int lane5 = ltid(wv) & 63;
      float* L = (float*)shm + wv * (8 * 328);
      const int NSU = 3072 * 8;
      if ((int)blockIdx.x < NSB) {
        if (wv < 4) {
          int u = blockIdx.x * 4 + wv;
          __builtin_amdgcn_s_setprio(3);
          if (u < 768) rwkv_scan_unit(p, u >> 3, u & 7, false, L, lane5);
          __builtin_amdgcn_s_setprio(0);
        } else {
          for (int u = blockIdx.x * 4 + (wv - 4); u < 15360; u += NSB * 4) rwkv_scan_unit(p, u >> 3, u & 7, true, L, lane5);
        }
      } else {
        int nb_ = (int)gridDim.x - NSB; asm volatile("" : "+s"(nb_));
        attn_phase(p, 0, AIN_NP, shm, wv, blockIdx.x - NSB, nb_);
        __syncthreads();
        for (int u = 15360 + ((int)blockIdx.x - NSB) * 8 + wv; u < NSU; u += nb_ * 8) rwkv_scan_unit(p, u >> 3, u & 7, true, L, lane5);
        __syncthreads();
        transpose_job(p.ffn_w_up, D, DFF2, DFF2, (u16*)(ws + WS_UP), (float*)shm, blockIdx.x - NSB, nb_, wv, p.norm_ffn, 1);
      }
    } break;
    case 6: {
      PH_TID
      const float* Y = (const float*)(ws + WS_Y);
      const u16* SV = (const u16*)(ws + WS_SCV);
      const u16* LOG_ = (const u16*)(ws + WS_LOG);
      const float* BONS = (const float*)(ws + WS_BONS);
      const int hl = lane >> 5, l2 = (lane & 31) * 2;
      const int nseg = nw / 12, hp = gw % 12, seg = gw / 12;
      if (seg < nseg) {
        const int rps = (MT + nseg - 1) / nseg;
        const int rbeg = seg * rps, rend = min(rbeg + rps, MT);
        const int h = hp * 2 + hl, c = h * 64 + l2;
        const float2 lw = *(const float2*)(p.a_ln_w + c), lbb = *(const float2*)(p.a_ln_b + c);
        float2 ny = {0.f, 0.f}; unsigned nv = 0, ng = 0; float nb = 0.f;
        if (rbeg < rend) {
          size_t o = (size_t)rbeg * TOKW + c;
          ny = *(const float2*)(Y + o); nv = *(const unsigned*)(SV + o); ng = *(const unsigned*)(LOG_ + o); nb = BONS[(size_t)rbeg * 24 + h];
        }
        for (int row = rbeg; row < rend; ++row) {
          const float2 y = ny; const unsigned uv = nv, ug = ng; const float bs = nb;
          if (row + 1 < rend) {
            size_t o = (size_t)(row + 1) * TOKW + c;
            ny = *(const float2*)(Y + o); nv = *(const unsigned*)(SV + o); ng = *(const unsigned*)(LOG_ + o); nb = BONS[(size_t)(row + 1) * 24 + h];
          }
          float mu = half_sum(y.x + y.y) * (1.f / 64.f);
          float d0 = y.x - mu, d1 = y.y - mu;
          float var = half_sum(d0 * d0 + d1 * d1) * (1.f / 64.f);
          float rs = rsqrtf(var + 64e-5f);
          float o0 = (d0 * rs * lw.x + lbb.x + bs * bflo(uv)) * bflo(ug);
          float o1 = (d1 * rs * lw.y + lbb.y + bs * bfhi(uv)) * bfhi(ug);
          *(unsigned*)(TM + (size_t)row * D + c) = pack2(o0, o1);
        }
      }
    } break;

    case 8: case 16: {
      PH_TID
      int layer = ph == 8 ? 0 : 1;
      norm_tokens(X, X + (size_t)MP * D, p.norm_ffn + (size_t)layer * D, H, nullptr, nullptr, wv);
    } break;

    case 10: case 18: {
      PH_TID
      int layer = ph == 10 ? 0 : 1;
      const u16* AV = (const u16*)(ws + WS_AV);
      u16* U = (u16*)(ws + WS_U);
      const float* cw = p.ffn_conv_w + (size_t)layer * 3 * DFF;
      const float* cb = p.ffn_conv_b + (size_t)layer * DFF;
      const float* sc = p.st_conv + (size_t)layer * 128 * 2 * DFF;
      const int NCG = DFF / 8;
      for (size_t i = GTID; i < (size_t)(MT / 8) * NCG; i += GTHREADS) {
        int rg = (int)(i / NCG), c = (int)(i % NCG) * 8;
        int row0 = rg * 8;
        bool smp = row0 >= MP;
        int t0 = smp ? 0 : (row0 & (SEQ - 1));
        float w0[8], w1[8], w2[8], bb[8], am1[8], am2[8];
#pragma unroll
        for (int j = 0; j < 8; ++j) {
          w0[j] = cw[c + j]; w1[j] = cw[DFF + c + j]; w2[j] = cw[2 * DFF + c + j]; bb[j] = cb[c + j];
          am1[j] = 0.f; am2[j] = 0.f;
        }
        if (smp) {
          int b = (row0 - MP) >> 3;
#pragma unroll
          for (int j = 0; j < 8; ++j) { am2[j] = sc[((size_t)b * 2 + 0) * DFF + c + j]; am1[j] = sc[((size_t)b * 2 + 1) * DFF + c + j]; }
        } else if (t0 > 0) {
          int rm1 = row0 - 1, rm2 = row0 - 2;
          asm volatile("" : "+v"(rm1), "+v"(rm2));
          bf16x8 x1 = *(const bf16x8*)(AV + (size_t)rm1 * DFF2 + c);
          bf16x8 x2 = *(const bf16x8*)(AV + (size_t)rm2 * DFF2 + c);
#pragma unroll
          for (int j = 0; j < 8; ++j) { am1[j] = bf2f((u16)x1[j]); am2[j] = bf2f((u16)x2[j]); }
        }
#pragma unroll
        for (int r = 0; r < 8; ++r) {
          bf16x8 xa = *(const bf16x8*)(AV + (size_t)(row0 + r) * DFF2 + c);
          bf16x8 xv = *(const bf16x8*)(AV + (size_t)(row0 + r) * DFF2 + DFF + c);
          bf16x8 ob;
#pragma unroll
          for (int j = 0; j < 8; ++j) {
            float a = bf2f((u16)xa[j]);
            float cv = bb[j] + am2[j] * w0[j] + am1[j] * w1[j] + a * w2[j];
            float u2 = 1.5957691216057308f * (cv + 0.044715f * cv * cv * cv);
            float g = cv * __builtin_amdgcn_rcpf(1.f + __expf(-u2));
            ob[j] = (short)f2bf(g * bf2f((u16)xv[j]));
            am2[j] = am1[j]; am1[j] = a;
          }
          *(bf16x8*)(U + (size_t)(row0 + r) * DFF + c) = ob;
        }
      }
    } break;

    case 12: {
      PH_TID
      norm_tokens(X, X + (size_t)MP * D, p.norm_mix + D, H, nullptr, nullptr, wv);
    } break;

    case 14: {
      PH_TID
      if (blockIdx.x < 48) {
        hgrn_prompt_mfma(p, blockIdx.x / 12, blockIdx.x % 12, shm, wv);
      } else {
        int nb_ = (int)gridDim.x - 48; asm volatile("" : "+s"(nb_));
        for (int c = blockIdx.x - 48; c < 128 * 12; c += nb_) hgrn_seq(p, c / 12, c % 12, true, shm, wv);
        __syncthreads();
        attn_phase(p, 1, BIN_N, shm, wv, blockIdx.x - 48, nb_);
      }
    } break;
    case 20: {
      PH_TID
      const float* O = (const float*)(ws + WS_Y);
      const int nseg = nw / 12, h = gw % 12, seg = gw / 12;
      if (seg < nseg) {
        const int rps = (MT + nseg - 1) / nseg;
        const int rbeg = seg * rps, rend = min(rbeg + rps, MT);
        const int c0 = h * 128 + lane * 2;
        const float gn0 = p.b_g_norm[lane * 2], gn1 = p.b_g_norm[lane * 2 + 1];
        float2 no = {0.f, 0.f}; unsigned ng = 0;
        if (rbeg < rend) { no = *(const float2*)(O + (size_t)rbeg * TOKW + c0); ng = *(const unsigned*)(PB + (size_t)rbeg * BIN_N + MEMW + 3 * TOKW + c0); }
        for (int row = rbeg; row < rend; ++row) {
          const float2 o = no; const unsigned ug = ng;
          if (row + 1 < rend) { no = *(const float2*)(O + (size_t)(row + 1) * TOKW + c0); ng = *(const unsigned*)(PB + (size_t)(row + 1) * BIN_N + MEMW + 3 * TOKW + c0); }
          float ss = wave_sum(o.x * o.x + o.y * o.y);
          float sc = rsqrtf(ss * (1.f / 128.f) + 1e-6f);
          float g0 = bflo(ug), g1 = bfhi(ug);
          float r0 = o.x * sc * gn0 * (g0 * sigmoidf_(g0));
          float r1 = o.y * sc * gn1 * (g1 * sigmoidf_(g1));
          *(unsigned*)(TM + (size_t)row * D + c0) = pack2(r0, r1);
        }
      }
    } break;
    case 21: {
      PH_TID
      for (int row = gw; row < MT; row += 2 * nw) {
        const int row2 = row + nw;
        const bool has2 = row2 < MT;
        const float* s1 = X + (size_t)row * D;
        const float* s2 = X + (size_t)(has2 ? row2 : row) * D;
        f32x4 v[8], u[8];
        float ss1 = 0.f, ss2 = 0.f;
#pragma unroll
        for (int i = 0; i < 8; ++i) { v[i] = ((const f32x4*)s1)[lane + 64 * i]; u[i] = ((const f32x4*)s2)[lane + 64 * i]; }
#pragma unroll
        for (int i = 0; i < 8; ++i) {
          ss1 += v[i][0] * v[i][0] + v[i][1] * v[i][1] + v[i][2] * v[i][2] + v[i][3] * v[i][3];
          ss2 += u[i][0] * u[i][0] + u[i][1] * u[i][1] + u[i][2] * u[i][2] + u[i][3] * u[i][3];
        }
        ss1 = wave_sum(ss1); ss2 = wave_sum(ss2);
        const float sc1 = rsqrtf(ss1 * (1.f / 2048.f) + 1e-6f), sc2 = rsqrtf(ss2 * (1.f / 2048.f) + 1e-6f);
        float* d1 = row < MP ? p.out + O_YP + (size_t)row * D : p.out + O_YS + (size_t)(row - MP) * D;
        float* d2 = row2 < MP ? p.out + O_YP + (size_t)row2 * D : p.out + O_YS + (size_t)(row2 - MP) * D;
#pragma unroll
        for (int i = 0; i < 8; ++i) {
          const f32x4 gg = ((const f32x4*)p.norm_final)[lane + 64 * i];
          __builtin_nontemporal_store(v[i] * sc1 * gg, (f32x4*)d1 + lane + 64 * i);
          if (has2) __builtin_nontemporal_store(u[i] * sc2 * gg, (f32x4*)d2 + lane + 64 * i);
        }
      }
    } break;
    default: break;
  }
}


#define XB_TMO      128
#define XB_XCNT(j)  (256  + 64 * (j))
#define XB_XSUB(j)  (1280 + 64 * (j))
#define XB_XGEN(j)  (2304 + 64 * (j))
#define XB_TOP      3328
#define XB_TOPGEN   3392
#define XCD_BAR_WORDS 3456
#define XB_SPIN_CAP (1u << 22)
#define LAS __attribute__((address_space(3)))
__device__ __forceinline__ unsigned xb_ld(unsigned* p) { return __hip_atomic_load(p, __ATOMIC_RELAXED, __HIP_MEMORY_SCOPE_AGENT); }
__device__ __forceinline__ unsigned xb_add(unsigned* p, unsigned v) { return __hip_atomic_fetch_add(p, v, __ATOMIC_RELAXED, __HIP_MEMORY_SCOPE_AGENT); }
__device__ __forceinline__ unsigned xb_xcc_id() { return (unsigned)__builtin_amdgcn_s_getreg((3 << 11) | 20) & 0xFu; }
#define XB_SPIN(cond, bar) do { unsigned _sp = 0; while (cond) { __builtin_amdgcn_s_sleep(1); \
    if ((++_sp & 255u) == 0u) { if (xb_ld(&(bar)[XB_TMO])) break; if (_sp > XB_SPIN_CAP) { atomicAdd(&(bar)[XB_TMO], 1u); break; } } } } while (0)

__device__ __forceinline__ void xcd_barrier_complete(unsigned* bar, unsigned x, unsigned& nloc, unsigned& nx) {
  const unsigned G = gridDim.x * gridDim.y * gridDim.z;
  unsigned sum, cnt, mine, sp = 0u;
  for (;;) {
    sum = 0u; cnt = 0u; mine = 0u;
#pragma unroll
    for (unsigned j = 0; j < 16; ++j) { const unsigned c = xb_ld(&bar[XB_XCNT(j)]); sum += c; cnt += (c > 0u) ? 1u : 0u; mine = (j == x) ? c : mine; }
    if (sum == G) break;
    __builtin_amdgcn_s_sleep(1);
    if ((++sp & 255u) == 0u) { if (xb_ld(&bar[XB_TMO])) break; if (sp > XB_SPIN_CAP) { atomicAdd(&bar[XB_TMO], 1u); break; } }
  }
  nloc = mine > 0u ? mine : 1u; nx = cnt > 0u ? cnt : 1u;
}

__device__ __forceinline__ void xcd_barrier(unsigned* bar, volatile LAS unsigned* st) {
  asm volatile("s_waitcnt vmcnt(0)" ::: "memory");
  __syncthreads();
  if (threadIdx.x == 0) {
    const unsigned x = xb_xcc_id();
    __builtin_amdgcn_s_waitcnt(0);
    unsigned nloc = st[0], nx = st[1];
    if (nloc == 0u) { xcd_barrier_complete(bar, x, nloc, nx); st[0] = nloc; st[1] = nx; }
    const unsigned old = xb_add(&bar[XB_XSUB(x)], 1u);
    const unsigned gen = old / nloc;
    if (old + 1u == (gen + 1u) * nloc) {
      __builtin_amdgcn_fence(__ATOMIC_RELEASE, "agent");
      asm volatile("s_waitcnt vmcnt(0)" ::: "memory");
      const unsigned og = xb_add(&bar[XB_TOP], 1u);
      const unsigned tg = og / nx;
      if (og + 1u == (tg + 1u) * nx) xb_add(&bar[XB_TOPGEN], 1u);
      else XB_SPIN(xb_ld(&bar[XB_TOPGEN]) == tg, bar);
      __builtin_amdgcn_fence(__ATOMIC_ACQUIRE, "agent");
      xb_add(&bar[XB_XGEN(x)], 1u);
      asm volatile("s_waitcnt vmcnt(0)" ::: "memory");
    } else {
      XB_SPIN(xb_ld(&bar[XB_XGEN(x)]) == gen, bar);
      __builtin_amdgcn_fence(__ATOMIC_ACQUIRE, "agent");
      asm volatile("s_waitcnt vmcnt(0)" ::: "memory");
    }
  }
  __syncthreads();
}

__constant__ int kOrder[NPHASE] = {0, 1, 2, 3, 4, 5, 6, 7, 9, 11, 13, 14, 20, 15, 17, 19, 21};

__global__ void __launch_bounds__(NTHREADS) mega_kernel(Params p_arg, int ph_begin, int ph_end, int coop) {
  extern __shared__ __attribute__((aligned(16))) char shm[];
  __shared__ uint4 xb_words;
  if (threadIdx.x == 0) {
    xb_words = make_uint4(0u, 0u, 0u, 0u);
    (void)xb_add(&((unsigned*)(p_arg.ws + WS_BAR))[XB_XCNT(xb_xcc_id())], 1u);
  }
  __syncthreads();
  int wv = __builtin_amdgcn_readfirstlane((int)(threadIdx.x >> 6));
  asm volatile("" : "+s"(wv));
  for (int i = ph_begin; i < ph_end; ++i) {
#if defined(__HIP_DEVICE_COMPILE__)
    Params p;
    load_params(p);
#else
    Params p = p_arg;
#endif
    int ph = kOrder[i];
    bool isg = (ph == 1) | (ph == 3) | (ph == 7) | (ph == 15) | (ph == 9) | (ph == 17) | (ph == 11) | (ph == 19) | (ph == 13);
    if (isg) gemm_phase(ph, shm, wv); else run_phase(p, ph, shm, wv);
    if (coop && i + 1 < ph_end) {
      if (coop == 2) {
        cg::this_grid().sync();
      } else {
        Params pb;
        load_params(pb);
        xcd_barrier((unsigned*)(pb.ws + WS_BAR), (volatile LAS unsigned*)&xb_words);
      }
    }
  }
}

extern "C" void kernel_launch(void* const* d_in, const int* in_sizes, int n_in, void* d_out, int out_size, void* d_ws,
                              size_t ws_size, hipStream_t stream) {
  static int grid_blocks = 0;
  if (!grid_blocks) {
    int dev = 0, cus = 0, per_cu = 0;
    hipGetDevice(&dev);
    hipDeviceGetAttribute(&cus, hipDeviceAttributeMultiprocessorCount, dev);
    hipFuncSetAttribute((const void*)mega_kernel, hipFuncAttributeMaxDynamicSharedMemorySize, SHM_BYTES);
    hipOccupancyMaxActiveBlocksPerMultiprocessor(&per_cu, mega_kernel, NTHREADS, SHM_BYTES);
    if (per_cu < 1) per_cu = 1;
    grid_blocks = cus * per_cu;
    if (grid_blocks > 256) grid_blocks = 256;
  }
  Params p{};
  const float** pp = (const float**)&p;
  for (int i = 0; i < 35; ++i) pp[i] = (const float*)d_in[i];
  p.out = (float*)d_out;
  p.ws = (char*)d_ws;
#ifdef MULTI_LAUNCH
  for (int i = 0; i < NPHASE; ++i) {
    hipLaunchKernelGGL(mega_kernel, dim3(grid_blocks), dim3(NTHREADS), SHM_BYTES, stream, p, i, i + 1, 0);
  }
#else
  hipMemsetAsync((char*)d_ws + WS_BAR, 0, XCD_BAR_WORDS * sizeof(unsigned), stream);
  int b = 0, e = NPHASE, c = 1;
  void* args[] = {&p, &b, &e, &c};
  hipError_t err = hipLaunchCooperativeKernel((void*)mega_kernel, dim3(grid_blocks), dim3(NTHREADS), args, SHM_BYTES, stream);
  if (err != hipSuccess) fprintf(stderr, "coop launch failed: %s\n", hipGetErrorString(err));
#endif
}
```

```cpp
#include <hip/hip_runtime.h>
#include <hip/hip_bf16.h>
#include <hip/hip_cooperative_groups.h>
#include <cstdio>
namespace cg = cooperative_groups;

typedef unsigned short u16;
using bf16x8 = __attribute__((ext_vector_type(8))) short;
using f32x4 = __attribute__((ext_vector_type(4))) float;
using u16x4 = __attribute__((ext_vector_type(4))) unsigned short;

#define NTHREADS 512
#define SHM_BYTES 147456

constexpr int D = 2048, MP = 8192, MS = 1024, MT = 9216, SEQ = 2048;
constexpr int TOKW = 1536, MEMW = 512, NMEM = 256;
constexpr int APROJ = 5056, AIN_N = 5568, AIN_NP = 5632, BIN_N = 6656;
constexpr int DFF = 5632, DFF2 = 11264;
constexpr int MA0 = 9472;
constexpr int LORA_K = 512, LORA_N = 4608;

constexpr long O_YP = 0, O_YS = 16777216, O_MK = 18874368, O_MV = 19922944, O_RP = 20971520, O_RS = 21364736,
               O_SP = 33947648, O_SS = 33955840, O_HP = 34217984, O_HS = 35004416, O_CP = 60170240, O_CS = 60260352;

constexpr size_t WS_AIN = 0;
constexpr size_t WS_BIN = WS_AIN + (size_t)AIN_NP * D * 2;
constexpr size_t WS_AOUT = WS_BIN + (size_t)BIN_N * D * 2;
constexpr size_t WS_BOUT = WS_AOUT + (size_t)D * D * 2;
constexpr size_t WS_UP = WS_BOUT + (size_t)D * D * 2;
constexpr size_t WS_DN = WS_UP + (size_t)2 * DFF2 * D * 2;
constexpr size_t WS_KV = WS_DN + (size_t)2 * D * DFF * 2;
constexpr size_t WS_LORA = WS_KV + (size_t)2 * 1024 * D * 2;
constexpr size_t WS_H = WS_LORA + (size_t)LORA_N * LORA_K * 2;
constexpr size_t WS_MH = WS_H + (size_t)MA0 * D * 2;
constexpr size_t WS_P = WS_MH + (size_t)2 * 1024 * D * 2;
constexpr size_t WS_X = WS_P + (size_t)MT * BIN_N * 2;
constexpr size_t WS_TM = WS_X + (size_t)MT * D * 4;
constexpr size_t WS_BIG = WS_TM + (size_t)MT * D * 2;
constexpr size_t WS_LA = WS_BIG;
constexpr size_t WS_LOD = WS_LA + (size_t)MT * LORA_K * 2;
constexpr size_t WS_LOA = WS_LOD + (size_t)MT * TOKW * 4;
constexpr size_t WS_LOG = WS_LOA + (size_t)MT * TOKW * 2;
constexpr size_t WS_SCR = WS_LOG + (size_t)MT * TOKW * 2;
constexpr size_t WS_SCK = WS_SCR + (size_t)MT * TOKW * 2;
constexpr size_t WS_SCV = WS_SCK + (size_t)MT * TOKW * 2;
constexpr size_t WS_SCKK = WS_SCV + (size_t)MT * TOKW * 2;
constexpr size_t WS_SCB = WS_SCKK + (size_t)MT * TOKW * 2;
constexpr size_t WS_BONS = WS_SCB + (size_t)MT * TOKW * 2;
constexpr size_t WS_Y = WS_BONS + (size_t)MT * 24 * 4;
constexpr size_t WS_AV = WS_BIG;
constexpr size_t WS_U = WS_AV + (size_t)MT * DFF2 * 2;
constexpr size_t WS_SS = WS_Y + (size_t)MT * TOKW * 4;
constexpr size_t WS_BAR = WS_SS + (size_t)3 * MT * 4 + 4096;
constexpr size_t WS_FLAG = WS_BAR + 16384;
constexpr size_t WS_PART = WS_FLAG + 4096;

struct Params {
  const float *x_prompt, *x_sample, *mem_prompt, *cache_k, *cache_v, *st_rwkv, *st_shift, *st_hgrn, *st_conv;
  const float *norm_mix, *norm_ffn, *norm_final, *mem_norm, *w_mem_kv, *a_w_in, *a_mu, *a_w0, *a_w2, *a_a0, *a_a2, *a_g2,
      *a_k_k, *a_k_a, *a_r_k, *a_ln_w, *a_ln_b, *a_w_out, *b_w_in, *b_lb, *b_g_norm, *b_w_out, *ffn_w_up, *ffn_conv_w,
      *ffn_conv_b, *ffn_w_down;
  float* out;
  char* ws;
};


__device__ __forceinline__ void load_params(Params& p) {
#if defined(__HIP_DEVICE_COMPILE__)
  unsigned long long kp = (unsigned long long)__builtin_amdgcn_kernarg_segment_ptr();
  asm volatile("" : "+s"(kp));
  const __attribute__((address_space(4))) unsigned long long* s4 = (const __attribute__((address_space(4))) unsigned long long*)kp;
  unsigned long long* d = (unsigned long long*)&p;
#pragma unroll
  for (int i = 0; i < (int)(sizeof(Params) / 8); ++i) d[i] = s4[i];
#endif
}
__device__ __forceinline__ int ltid(int wv) {
  int l;
  asm volatile("v_mbcnt_lo_u32_b32 %0, -1, 0\n\tv_mbcnt_hi_u32_b32 %0, -1, %0" : "=v"(l));
  return (wv << 6) | l;
}
__device__ __forceinline__ u16 f2bf(float f) {
  return __builtin_bit_cast(u16, (__bf16)f);
}
__device__ __forceinline__ float bf2f(u16 h) { return __uint_as_float(((unsigned)h) << 16); }
template <int CTRL>
__device__ __forceinline__ float dpp_add(float x) {
  int y = __builtin_amdgcn_update_dpp(0, __float_as_int(x), CTRL, 0xf, 0xf, true);
  return x + __int_as_float(y);
}
__device__ __forceinline__ float wave_sum(float v) {
  v = dpp_add<0xB1>(v);
  v = dpp_add<0x4E>(v);
  v = dpp_add<0x141>(v);
  v = dpp_add<0x140>(v);
  int iv = __float_as_int(v);
  float a = __int_as_float(__builtin_amdgcn_readlane(iv, 0));
  float b = __int_as_float(__builtin_amdgcn_readlane(iv, 16));
  float c = __int_as_float(__builtin_amdgcn_readlane(iv, 32));
  float d = __int_as_float(__builtin_amdgcn_readlane(iv, 48));
  return (a + b) + (c + d);
}

__device__ __forceinline__ float half_sum(float v) {
  v = dpp_add<0xB1>(v);
  v = dpp_add<0x4E>(v);
  v = dpp_add<0x141>(v);
  v = dpp_add<0x140>(v);
  int o = __builtin_amdgcn_ds_swizzle(__float_as_int(v), 0x401F);
  return v + __int_as_float(o);
}
__device__ __forceinline__ float bflo(unsigned u) { return __uint_as_float(u << 16); }
__device__ __forceinline__ float bfhi(unsigned u) { return __uint_as_float(u & 0xffff0000u); }
__device__ __forceinline__ unsigned pack2(float a, float b) { return (unsigned)f2bf(a) | ((unsigned)f2bf(b) << 16); }
__device__ __forceinline__ float sigmoidf_(float x) { return 1.f / (1.f + __expf(-x)); }
__device__ __forceinline__ int prev_row(int row) {
  if (row < MP) return (row & (SEQ - 1)) == 0 ? -1 : row - 1;
  int s = row - MP;
  return (s & 7) == 0 ? MT + (s >> 3) : row - 1;
}

constexpr int BM = 256, BK = 64, HALF = 128, NXCD = 8, WGM = 8, HT = HALF * BK;

__device__ __forceinline__ int lds_byte(int r, int c) {
  int st = (r >> 4) * 2 + (c >> 5), rr = r & 15, cc = c & 31, ob = rr * 64 + cc * 2;
  return st * 1024 + (ob ^ (((ob >> 9) & 1) << 5));
}
__device__ __forceinline__ void stage_rc(int b, int& R, int& C) {
  int st = b / 1024, sb = b % 1024, swz = sb ^ (((sb >> 9) & 1) << 5);
  R = (st >> 1) * 16 + swz / 64;
  C = (st & 1) * 32 + (swz % 64) / 2;
}

__device__ __forceinline__ float epi_store(const Params& p, int ph, int tglob, int row, int col, f32x4 v, f32x4 cvec, float rs) {
  char* ws = p.ws;
  const int T2 = (MA0 / BM) * (AIN_NP / BM);
  if (ph == 1 && tglob >= T2) {
    int l = (tglob - T2) >> 4;
    float* f0 = p.out + O_MK + (size_t)l * 1024 * MEMW;
    float* f1 = p.out + O_MV + (size_t)l * 1024 * MEMW;
    if (col < MEMW) *(f32x4*)(f0 + (size_t)row * MEMW + col) = v;
    else *(f32x4*)(f1 + (size_t)row * MEMW + (col - MEMW)) = v;
  } else if (ph == 1 || ph == 13 || ph == 9 || ph == 17) {
    int ld = ph == 1 ? AIN_NP : (ph == 13 ? BIN_N : DFF2);
    u16* ob = (u16*)(ws + ((ph == 9 || ph == 17) ? WS_AV : WS_P));
    if (ph != 1 && row >= MT) return 0.f;
    if (ph != 1) v *= rs;
    if (ph == 13) {
      if (col >= MEMW && col < MEMW + TOKW) {
#pragma unroll
        for (int i = 0; i < 4; ++i) v[i] = v[i] * __builtin_amdgcn_rcpf(1.f + __expf(-v[i]));
      } else if (col >= MEMW + TOKW && col < MEMW + 2 * TOKW) {
#pragma unroll
        for (int i = 0; i < 4; ++i) v[i] = __logf(cvec[i] + (1.f - cvec[i]) * __builtin_amdgcn_rcpf(1.f + __expf(-v[i])));
      }
    }
    u16x4 o;
    o[0] = f2bf(v[0]); o[1] = f2bf(v[1]); o[2] = f2bf(v[2]); o[3] = f2bf(v[3]);
    *(u16x4*)(ob + (size_t)row * ld + col) = o;
    if ((ph == 9 || ph == 17) && col < DFF) {
      int layer = ph == 9 ? 0 : 1;
      if (row < MP) {
        int t = row & (SEQ - 1), b = row >> 11;
        if (t >= SEQ - 2) *(f32x4*)(p.out + O_CP + ((size_t)((layer * 4 + b) * 2 + (t - (SEQ - 2)))) * DFF + col) = v;
      } else {
        int s = row - MP, t = s & 7, b = s >> 3;
        if (t >= 6) *(f32x4*)(p.out + O_CS + ((size_t)((layer * 128 + b) * 2 + (t - 6))) * DFF + col) = v;
      }
    }
  } else if (ph == 3) {
    int blk = col / TOKW, c = col - blk * TOKW;
    if (blk == 0) {
      f32x4 o;
#pragma unroll
      for (int i = 0; i < 4; ++i) {
        float z = cvec[i] + v[i];
        float w = -__logf(1.f + __expf(-z)) - 0.5f;
        o[i] = __expf(-__expf(w));
      }
      *(f32x4*)((float*)(ws + WS_LOD) + (size_t)row * TOKW + c) = o;
    } else if (blk == 1) {
      u16x4 o;
#pragma unroll
      for (int i = 0; i < 4; ++i) o[i] = f2bf(__builtin_amdgcn_rcpf(1.f + __expf(-(cvec[i] + v[i]))));
      *(u16x4*)((u16*)(ws + WS_LOA) + (size_t)row * TOKW + c) = o;
    } else {
      u16x4 o;
#pragma unroll
      for (int i = 0; i < 4; ++i) o[i] = f2bf(v[i]);
      *(u16x4*)((u16*)(ws + WS_LOG) + (size_t)row * TOKW + c) = o;
    }
  } else if (tglob >= 256 && ((tglob - 256) & 3)) {
    const int pi = ((ph == 7 ? 0 : (ph == 11 ? 1 : (ph == 15 ? 2 : 3))) * 32 + ((tglob - 256) >> 2)) * 3 + (((tglob - 256) & 3) - 1);
    unsigned long long pk = (unsigned long long)f2bf(v[0]) | ((unsigned long long)f2bf(v[1]) << 16) |
                            ((unsigned long long)f2bf(v[2]) << 32) | ((unsigned long long)f2bf(v[3]) << 48);
    u16* pb = (u16*)(ws + WS_PART) + (size_t)pi * 65536 + (size_t)(row & 255) * 256 + (col & 255);
    __hip_atomic_store((unsigned long long*)pb, pk, __ATOMIC_RELAXED, __HIP_MEMORY_SCOPE_AGENT);
  } else {
    float* X = (float*)(ws + WS_X);
    const float* xin;
    if (ph == 7) xin = row < MP ? p.x_prompt + (size_t)row * D : p.x_sample + (size_t)(row - MP) * D;
    else xin = X + (size_t)row * D;
    f32x4 x = *(const f32x4*)(xin + col);
    x += v;
    *(f32x4*)(X + (size_t)row * D + col) = x;
    if (ph != 19) {
      u16x4 hb;
      hb[0] = f2bf(x[0]); hb[1] = f2bf(x[1]); hb[2] = f2bf(x[2]); hb[3] = f2bf(x[3]);
      *(u16x4*)((u16*)(ws + WS_H) + (size_t)row * D + col) = hb;
    }
    return x[0] * x[0] + x[1] * x[1] + x[2] * x[2] + x[3] * x[3];
  }
  return 0.f;
}


__device__ __forceinline__ void gemm_tile(const u16* __restrict__ A, const u16* __restrict__ Bt, int M, int N, int K,
                                          int wgid, int ph, int tglob, u16* shm, int wv, int nt) {
#define SA(b, h) (shm + ((b)*2 + (h)) * HT)
#define SB(b, h) (shm + (4 + (b)*2 + (h)) * HT)
#define STAGE(P, BASE, br, kt)                                                                            \
  do {                                                                                                    \
    const u16* _g = BASE + (long)(br)*K + (long)(kt)*BK;                                                  \
    __builtin_amdgcn_global_load_lds((const unsigned*)(_g + soff0), (unsigned*)((char*)(P) + wv * 1024), 16, 0, 0);        \
    __builtin_amdgcn_global_load_lds((const unsigned*)(_g + soff1), (unsigned*)((char*)(P) + wv * 1024 + 8192), 16, 0, 0); \
  } while (0)
#define LDA(dst, b, h)                                                                                    \
  _Pragma("unroll") for (int m = 0; m < 4; ++m)                                                           \
    _Pragma("unroll") for (int k = 0; k < 2; ++k)                                                         \
  dst[m][k] = *reinterpret_cast<const bf16x8*>(abase + (((b)*2 + (h)) * 16384 + (m * 2 + k) * 1024))
#define LDB(dst, b, h)                                                                                    \
  _Pragma("unroll") for (int n = 0; n < 2; ++n)                                                           \
    _Pragma("unroll") for (int k = 0; k < 2; ++k)                                                         \
  dst[n][k] = *reinterpret_cast<const bf16x8*>(bbase + (((b)*2 + (h)) * 16384 + (n * 2 + k) * 1024))
#define MMA(ai, bj, At, Bt_)                                                                              \
  do {                                                                                                    \
    __builtin_amdgcn_s_setprio(1);                                                                        \
    _Pragma("unroll") for (int m = 0; m < 4; ++m)                                                         \
      _Pragma("unroll") for (int n = 0; n < 2; ++n)                                                       \
        _Pragma("unroll") for (int k = 0; k < 2; ++k)                                                     \
          acc[ai][bj][m][n] =                                                                             \
              __builtin_amdgcn_mfma_f32_16x16x32_bf16(Bt_[n][k], At[m][k], acc[ai][bj][m][n], 0, 0, 0);   \
    __builtin_amdgcn_s_setprio(0);                                                                        \
  } while (0)
#define WAIT_V(n) asm volatile("s_waitcnt vmcnt(" #n ")" ::: "memory")
#define WAIT_L(n) asm volatile("s_waitcnt lgkmcnt(" #n ")" ::: "memory")
#define BAR __builtin_amdgcn_s_barrier()
#define SCHED __builtin_amdgcn_sched_barrier(0)

  const int tx = ltid(wv);
  unsigned soff0, soff1;
  {
    int r_, c_;
    stage_rc(tx * 16, r_, c_);
    soff0 = (unsigned)(r_ * K + c_);
    stage_rc(tx * 16 + 8192, r_, c_);
    soff1 = (unsigned)(r_ * K + c_);
  }
  int nM = M / BM, nN = N / BM, nwg = nM * nN;
  {
    int q = nwg / NXCD, r = nwg % NXCD, xcd = wgid % NXCD, off = wgid / NXCD;
    wgid = (xcd < r ? xcd * (q + 1) : r * (q + 1) + (xcd - r) * q) + off;
  }
  int nig = WGM * nN, gid = wgid / nig, fm = gid * WGM, gsz = min(nM - fm, WGM);
  int pm = fm + ((wgid % nig) % gsz), pn = (wgid % nig) / gsz, brow = pm * BM, bcol = pn * BM;
  if (ph == 9 || ph == 17) brow = pm * 254 - 2;
  int wid = tx >> 6, lane = tx & 63, wr = wid >> 2, wc = wid & 3, fr = lane & 15, fq = lane >> 4;
  const int swz_ = (fr * 64 + fq * 16) ^ ((((fr * 64 + fq * 16) >> 9) & 1) << 5);
  const char* abase = (const char*)shm + swz_ + wr * 8192;
  const char* bbase = (const char*)shm + swz_ + wc * 4096 + 65536;
  f32x4 acc[2][2][4][2] = {};
  bf16x8 At[4][2], B0[2][2], B1[2][2];
  STAGE(SB(0, 0), Bt, bcol, 0); STAGE(SA(0, 0), A, brow, 0);
  STAGE(SB(0, 1), Bt, bcol + HALF, 0); STAGE(SA(0, 1), A, brow + HALF, 0);
  if (wr == 1) BAR;
  WAIT_V(4); BAR;
  STAGE(SB(1, 0), Bt, bcol, 1); STAGE(SA(1, 0), A, brow, 1); STAGE(SB(1, 1), Bt, bcol + HALF, 1);
  WAIT_V(6); BAR;
  for (int t = 0; t < nt - 2; t += 2) {
    LDB(B0, 0, 0); SCHED; LDA(At, 0, 0); STAGE(SA(1, 1), A, brow + HALF, t + 1);
    WAIT_L(8); BAR; WAIT_L(0); MMA(0, 0, At, B0); BAR; SCHED;
    LDB(B1, 0, 1); STAGE(SB(0, 0), Bt, bcol, t + 2);
    BAR; WAIT_L(0); MMA(0, 1, At, B1); BAR;
    LDA(At, 0, 1); STAGE(SA(0, 0), A, brow, t + 2);
    BAR; WAIT_L(0); MMA(1, 0, At, B0); BAR; SCHED;
    STAGE(SB(0, 1), Bt, bcol + HALF, t + 2);
    WAIT_V(6); BAR; MMA(1, 1, At, B1); BAR;
    LDB(B0, 1, 0); SCHED; LDA(At, 1, 0); STAGE(SA(0, 1), A, brow + HALF, t + 2);
    WAIT_L(8); BAR; WAIT_L(0); MMA(0, 0, At, B0); BAR; SCHED;
    LDB(B1, 1, 1); STAGE(SB(1, 0), Bt, bcol, t + 3);
    BAR; WAIT_L(0); MMA(0, 1, At, B1); BAR;
    LDA(At, 1, 1); STAGE(SA(1, 0), A, brow, t + 3);
    BAR; WAIT_L(0); MMA(1, 0, At, B0); BAR; SCHED;
    STAGE(SB(1, 1), Bt, bcol + HALF, t + 3);
    WAIT_V(6); BAR; MMA(1, 1, At, B1); BAR;
  }
  { LDB(B0, 0, 0); LDA(At, 0, 0); STAGE(SA(1, 1), A, brow + HALF, nt - 1);
    BAR; WAIT_L(0); MMA(0, 0, At, B0); BAR;
    LDB(B1, 0, 1); BAR; WAIT_L(0); MMA(0, 1, At, B1); BAR;
    LDA(At, 0, 1); WAIT_V(4); BAR; WAIT_L(0); MMA(1, 0, At, B0); MMA(1, 1, At, B1); BAR; }
  { LDB(B0, 1, 0); LDA(At, 1, 0); WAIT_V(2); BAR; WAIT_L(0); MMA(0, 0, At, B0); BAR;
    LDB(B1, 1, 1); WAIT_V(0); BAR; WAIT_L(0); MMA(0, 1, At, B1); BAR;
    LDA(At, 1, 1); BAR; WAIT_L(0); MMA(1, 0, At, B0); MMA(1, 1, At, B1); BAR; }
  if (wr == 0) BAR;
  {
    float* tl = (float*)shm;
    Params p2;
    load_params(p2);
    const int tx2 = ltid(wv);
    const int wid2 = tx2 >> 6, lane2 = tx2 & 63;
    const int wr = wid2 >> 2, wc = wid2 & 3, fr = lane2 & 15, fq = lane2 >> 4;
    const int tx = tx2;
    const bool sk_unit = (ph == 7 || ph == 11 || ph == 15 || ph == 19) && tglob >= 256;
    const bool sk_part1 = sk_unit && ((tglob - 256) & 3);
    const bool sk_part0 = sk_unit && !((tglob - 256) & 3);
    const int sk_idx = (ph == 7 ? 0 : (ph == 11 ? 1 : (ph == 15 ? 2 : 3))) * 32 + (sk_unit ? ((tglob - 256) >> 2) : 0);
    int* flagp = (int*)(p2.ws + WS_FLAG) + sk_idx;
    const u16* partp = (const u16*)(p2.ws + WS_PART) + (size_t)sk_idx * 3 * 65536;
    if (sk_part0) {
      if (tx == 0) {
        while (__hip_atomic_load(flagp, __ATOMIC_RELAXED, __HIP_MEMORY_SCOPE_AGENT) < 3) __builtin_amdgcn_s_sleep(4);
      }
      __syncthreads();
      __builtin_amdgcn_fence(__ATOMIC_ACQUIRE, "agent");
    }
    if ((ph == 9 || ph == 13 || ph == 17) && tx < 256) {
      int si = ph == 9 ? 0 : (ph == 13 ? 1 : 2);
      int row = brow + tx;
      float ssv = (row >= 0 && row < MT) ? ((const float*)(p2.ws + WS_SS))[si * MT + row] : 0.f;
      ((float*)((char*)shm + 133120 + 1024))[tx] = rsqrtf(ssv * (1.f / 2048.f) + 1e-6f);
    }
#pragma unroll
    for (int ai = 0; ai < 2; ++ai) {
      __syncthreads();
#pragma unroll
      for (int bj = 0; bj < 2; ++bj)
#pragma unroll
        for (int m = 0; m < 4; ++m)
#pragma unroll
          for (int n = 0; n < 2; ++n) {
            int r = wr * 64 + m * 16 + fr;
            int c = bj * HALF + wc * 32 + n * 16 + fq * 4;
            *(f32x4*)(tl + r * 260 + c) = acc[ai][bj][m][n];
          }
      __syncthreads();
      if ((ph == 7 || ph == 11 || ph == 15 || ph == 19) && !sk_part1) {
        float* X = (float*)(p2.ws + WS_X);
        u16* Hb = (u16*)(p2.ws + WS_H);
        f32x4 xr[16];
#pragma unroll
        for (int it = 0; it < 16; ++it) {
          int idx = tx + it * NTHREADS;
          int row = brow + ai * HALF + (idx >> 6), col = bcol + (idx & 63) * 4;
          const float* xin;
          if (ph == 7) xin = row < MP ? p2.x_prompt + (size_t)row * D : p2.x_sample + (size_t)(row - MP) * D;
          else xin = X + (size_t)row * D;
          xr[it] = *(const f32x4*)(xin + col);
          if (sk_part0) {
#pragma unroll
            for (int q = 0; q < 3; ++q) {
              u16x4 pp = *(const u16x4*)(partp + (size_t)q * 65536 + (size_t)(row & 255) * 256 + (col & 255));
              xr[it][0] += bf2f(pp[0]); xr[it][1] += bf2f(pp[1]); xr[it][2] += bf2f(pp[2]); xr[it][3] += bf2f(pp[3]);
            }
          }
        }
#pragma unroll
        for (int it = 0; it < 16; ++it) {
          int idx = tx + it * NTHREADS;
          int r = idx >> 6, c4 = idx & 63;
          int row = brow + ai * HALF + r, col = bcol + c4 * 4;
          f32x4 x = xr[it] + *(const f32x4*)(tl + r * 260 + c4 * 4);
          *(f32x4*)(X + (size_t)row * D + col) = x;
          if (ph != 19) {
            u16x4 hb;
            hb[0] = f2bf(x[0]); hb[1] = f2bf(x[1]); hb[2] = f2bf(x[2]); hb[3] = f2bf(x[3]);
            *(u16x4*)(Hb + (size_t)row * D + col) = hb;
            float s = wave_sum(x[0] * x[0] + x[1] * x[1] + x[2] * x[2] + x[3] * x[3]);
            if ((tx & 63) == 0) ((float*)((char*)shm + 133120))[ai * HALF + r] = s;
          }
        }
      } else if (ph == 9 || ph == 17) {
        const int layer = ph == 9 ? 0 : 1;
        const int c4 = tx & 31, rb = tx >> 5;
        const int ch = (bcol >> 8) * 128 + c4 * 4;
        const float* cw = p2.ffn_conv_w + (size_t)layer * 3 * DFF;
        const f32x4 w0 = *(const f32x4*)(cw + ch), w1 = *(const f32x4*)(cw + DFF + ch), w2 = *(const f32x4*)(cw + 2 * DFF + ch);
        const f32x4 bb = *(const f32x4*)(p2.ffn_conv_b + (size_t)layer * DFF + ch);
        const float* rsb = (const float*)((char*)shm + 133120 + 1024);
        float* halo = (float*)((char*)shm + 133120 + 2048);
        u16* U = (u16*)(p2.ws + WS_U);
#pragma unroll 1
        for (int it = 0; it < 8; ++it) {
          const int r = rb + it * 16, tr = ai * HALF + r, grow = brow + tr;
          f32x4 a0 = *(const f32x4*)(tl + r * 260 + c4 * 4) * rsb[tr];
          f32x4 vv = *(const f32x4*)(tl + r * 260 + 128 + c4 * 4) * rsb[tr];
          f32x4 am1, am2;
          if (r >= 1) am1 = *(const f32x4*)(tl + (r - 1) * 260 + c4 * 4) * rsb[tr - 1];
          else am1 = *(const f32x4*)(halo + 128 + c4 * 4);
          if (r >= 2) am2 = *(const f32x4*)(tl + (r - 2) * 260 + c4 * 4) * rsb[tr - 2];
          else am2 = *(const f32x4*)(halo + r * 128 + c4 * 4);
          if (ai == 0 && r >= 126) *(f32x4*)(halo + (r - 126) * 128 + c4 * 4) = a0;
          if (tr >= 2 && grow < MT) {
            int t, b; const bool smp = grow >= MP;
            if (!smp) { t = grow & (SEQ - 1); b = grow >> 11; } else { int s = grow - MP; t = s & 7; b = s >> 3; }
            if (t < 2) {
              const float* sc = p2.st_conv + ((size_t)(layer * 128 + b) * 2) * DFF + ch;
              f32x4 z = {0.f, 0.f, 0.f, 0.f};
              if (t == 0) { am1 = smp ? *(const f32x4*)(sc + DFF) : z; am2 = smp ? *(const f32x4*)(sc) : z; }
              else { am2 = smp ? *(const f32x4*)(sc + DFF) : z; }
            }
            u16x4 ob;
#pragma unroll
            for (int j = 0; j < 4; ++j) {
              float cv = bb[j] + am2[j] * w0[j] + am1[j] * w1[j] + a0[j] * w2[j];
              float u2 = 1.5957691216057308f * (cv + 0.044715f * cv * cv * cv);
              float g = cv * __builtin_amdgcn_rcpf(1.f + __expf(-u2));
              ob[j] = f2bf(g * vv[j]);
            }
            *(u16x4*)(U + (size_t)grow * DFF + ch) = ob;
            const int Tn = smp ? 8 : SEQ;
            if (t >= Tn - 2) {
              float* co = smp ? p2.out + O_CS + ((size_t)(layer * 128 + b) * 2 + (t - 6)) * DFF + ch
                              : p2.out + O_CP + ((size_t)(layer * 4 + b) * 2 + (t - (SEQ - 2))) * DFF + ch;
              *(f32x4*)co = a0;
            }
          }
        }
      } else {
        const int c4 = tx & 63, rb = tx >> 6;
        const int col = bcol + c4 * 4;
        f32x4 cvec = {0.f, 0.f, 0.f, 0.f};
        if (ph == 3) {
          int blk = col / TOKW, c = col - blk * TOKW;
          if (blk == 0) cvec = *(const f32x4*)(p2.a_w0 + c);
          else if (blk == 1) cvec = *(const f32x4*)(p2.a_a0 + c);
        } else if (ph == 13 && col >= MEMW + TOKW && col < MEMW + 2 * TOKW) {
          const int cc = col - (MEMW + TOKW);
#pragma unroll
          for (int i = 0; i < 4; ++i) cvec[i] = __builtin_amdgcn_rcpf(1.f + __expf(p2.b_lb[cc + i] - p2.b_lb[TOKW + cc + i]));
        }
        const float* rsb = (const float*)((char*)shm + 133120 + 1024);
        const bool fused = (ph == 9 || ph == 13 || ph == 17);
#pragma unroll 1
        for (int it = 0; it < 16; ++it) {
          int r = rb + it * 8;
          f32x4 v = *(const f32x4*)(tl + r * 260 + c4 * 4);
          float rs = fused ? rsb[ai * HALF + r] : 1.f;
          epi_store(p2, ph, tglob, brow + ai * HALF + r, col, v, cvec, rs);
        }
      }
    }
    __syncthreads();
    if (sk_part1) {
      asm volatile("s_waitcnt vmcnt(0)" ::: "memory");
      __syncthreads();
      if (tx == 0) __hip_atomic_fetch_add(flagp, 1, __ATOMIC_RELAXED, __HIP_MEMORY_SCOPE_AGENT);
    }
    if ((ph == 7 || ph == 11 || ph == 15) && !sk_part1 && tx < 256) {
      int si = ph == 7 ? 0 : (ph == 11 ? 1 : 2);
      unsafeAtomicAdd((float*)(p2.ws + WS_SS) + si * MT + brow + tx, ((const float*)((char*)shm + 133120))[tx]);
    }
    __syncthreads();
  }
  WAIT_V(0);
#undef SA
#undef SB
#undef STAGE
#undef LDA
#undef LDB
#undef MMA
}

__device__ __forceinline__ void transpose_job(const float* __restrict__ src, int K, int N, int Npad, u16* __restrict__ dst, float* tile,
                              int start, int stride, int wv, const float* __restrict__ gain = nullptr, int perm = 0) {
  const int nk = K / 64, nn = Npad / 256, nt = nk * nn;
  const int tid = ltid(wv);
  const int kr = tid >> 6, nc = (tid & 63) * 4;
  for (int t = start; t < nt; t += stride) {
    const int tn = t % nn, tk = t / nn;
    const int k0 = tk * 64, n0 = tn * 256;
    f32x4 v[8];
#pragma unroll
    for (int h = 0; h < 8; ++h) {
      const int k = kr + h * 8;
      v[h] = (f32x4){0.f, 0.f, 0.f, 0.f};
      if (n0 + nc < N) v[h] = *(const f32x4*)(src + (size_t)(k0 + k) * N + n0 + nc);
    }
#pragma unroll
    for (int h = 0; h < 8; ++h) {
      const int k = kr + h * 8;
      if (gain) v[h] *= gain[k0 + k];
      *(f32x4*)(tile + k * 260 + nc) = v[h];
    }
    __syncthreads();
    const int n = tid >> 1, kh = (tid & 1) * 32;
    int ng = n0 + n;
    if (perm) {
      int part = ng >= DFF ? 1 : 0, m = ng - part * DFF;
      ng = (m >> 7) * 256 + part * 128 + (m & 127);
    }
    u16* dp = dst + (size_t)ng * K + k0 + kh;
#pragma unroll
    for (int q = 0; q < 4; ++q) {
      bf16x8 o;
#pragma unroll
      for (int i = 0; i < 8; ++i) o[i] = (short)f2bf(tile[(kh + q * 8 + i) * 260 + n]);
      *(bf16x8*)(dp + q * 8) = o;
    }
    __syncthreads();
  }
}

__device__ __forceinline__ void norm_row_wave(const float* __restrict__ src, const float* __restrict__ g,
                                              u16* __restrict__ dst, float* __restrict__ dstf, int lane) {
  f32x4 v[8];
  float ss = 0.f;
#pragma unroll
  for (int i = 0; i < 8; ++i) {
    v[i] = ((const f32x4*)src)[lane + 64 * i];
    ss += v[i][0] * v[i][0] + v[i][1] * v[i][1] + v[i][2] * v[i][2] + v[i][3] * v[i][3];
  }
  ss = wave_sum(ss);
  float sc = rsqrtf(ss * (1.f / 2048.f) + 1e-6f);
#pragma unroll
  for (int i = 0; i < 8; ++i) {
    f32x4 gg = ((const f32x4*)g)[lane + 64 * i];
    f32x4 o = v[i] * sc * gg;
    if (dst) {
      u16x4 ob;
      ob[0] = f2bf(o[0]); ob[1] = f2bf(o[1]); ob[2] = f2bf(o[2]); ob[3] = f2bf(o[3]);
      ((u16x4*)dst)[lane + 64 * i] = ob;
    }
    if (dstf) ((f32x4*)dstf)[lane + 64 * i] = o;
  }
}

__device__ __forceinline__ void norm_tokens(const float* xp, const float* xs, const float* g, u16* H, float* outp, float* outs, int wv) {
  const int tx = ltid(wv);
  int gw = blockIdx.x * 8 + (tx >> 6), nw = gridDim.x * 8, lane = tx & 63;
  for (int row = gw; row < MT; row += nw) {
    const float* src = row < MP ? xp + (size_t)row * D : xs + (size_t)(row - MP) * D;
    float* df = nullptr;
    if (outp) df = row < MP ? outp + (size_t)row * D : outs + (size_t)(row - MP) * D;
    norm_row_wave(src, g, H ? H + (size_t)row * D : nullptr, df, lane);
  }
}

__device__ __forceinline__ void attn_item(const u16* __restrict__ q, int ldq, int nq, const float* __restrict__ kb,
                          const float* __restrict__ vb, u16* __restrict__ o, int ldo, char* shm, int wv) {
  u16* Ks = (u16*)shm;
  u16* Vt = (u16*)(shm + 256 * 272);
  int tid = ltid(wv);
  __syncthreads();
#pragma unroll 4
  for (int i = 0; i < 16; ++i) {
    int idx = tid + 512 * i;
    int key = idx >> 5, d4 = idx & 31;
    f32x4 v = *(const f32x4*)(kb + (size_t)key * 512 + d4 * 4);
    u16x4 ob;
    ob[0] = f2bf(v[0]); ob[1] = f2bf(v[1]); ob[2] = f2bf(v[2]); ob[3] = f2bf(v[3]);
    *(u16x4*)(Ks + key * 136 + d4 * 4) = ob;
  }
#pragma unroll 2
  for (int i = 0; i < 8; ++i) {
    int idx = tid + 512 * i;
    int kp = idx >> 5, d4 = idx & 31;
    f32x4 v0 = *(const f32x4*)(vb + (size_t)(2 * kp) * 512 + d4 * 4);
    f32x4 v1 = *(const f32x4*)(vb + (size_t)(2 * kp + 1) * 512 + d4 * 4);
#pragma unroll
    for (int j = 0; j < 4; ++j) {
      unsigned pk = (unsigned)f2bf(v0[j]) | ((unsigned)f2bf(v1[j]) << 16);
      *(unsigned*)(Vt + (d4 * 4 + j) * 264 + 2 * kp) = pk;
    }
  }
  __syncthreads();
  int wid = tid >> 6, lane = tid & 63, fr = lane & 15, fq = lane >> 4;
  for (int q0 = wid * 16; q0 < nq; q0 += 128) {
    int qr = min(q0 + fr, nq - 1);
    bf16x8 qf[4];
#pragma unroll
    for (int ks = 0; ks < 4; ++ks) qf[ks] = *(const bf16x8*)(q + (size_t)qr * ldq + ks * 32 + fq * 8);
    f32x4 st[16];
#pragma unroll
    for (int kt = 0; kt < 16; ++kt) {
      f32x4 a = {0.f, 0.f, 0.f, 0.f};
#pragma unroll
      for (int ks = 0; ks < 4; ++ks) {
        bf16x8 kf = *(const bf16x8*)(Ks + (kt * 16 + fr) * 136 + ks * 32 + fq * 8);
        a = __builtin_amdgcn_mfma_f32_16x16x32_bf16(kf, qf[ks], a, 0, 0, 0);
      }
      st[kt] = a;
      __builtin_amdgcn_sched_barrier(0);
    }
    const float scale = 0.08838834764831845f;
    float mx = -1e30f;
#pragma unroll
    for (int kt = 0; kt < 16; ++kt)
#pragma unroll
      for (int j = 0; j < 4; ++j) mx = fmaxf(mx, st[kt][j]);
    mx = fmaxf(mx, __int_as_float(__builtin_amdgcn_ds_bpermute((lane ^ 16) << 2, __float_as_int(mx))));
    mx = fmaxf(mx, __int_as_float(__builtin_amdgcn_ds_bpermute((lane ^ 32) << 2, __float_as_int(mx))));
    float sum = 0.f;
#pragma unroll
    for (int kt = 0; kt < 16; ++kt)
#pragma unroll
      for (int j = 0; j < 4; ++j) {
        float pv = __expf((st[kt][j] - mx) * scale);
        st[kt][j] = pv;
        sum += pv;
      }
    sum += __int_as_float(__builtin_amdgcn_ds_bpermute((lane ^ 16) << 2, __float_as_int(sum)));
    sum += __int_as_float(__builtin_amdgcn_ds_bpermute((lane ^ 32) << 2, __float_as_int(sum)));
    float inv = 1.f / sum;
    f32x4 oa[8];
#pragma unroll
    for (int dt = 0; dt < 8; ++dt) oa[dt] = (f32x4){0.f, 0.f, 0.f, 0.f};
#pragma unroll
    for (int sl = 0; sl < 8; ++sl) {
      bf16x8 pb;
#pragma unroll
      for (int j = 0; j < 4; ++j) {
        pb[j] = (short)f2bf(st[2 * sl][j]);
        pb[4 + j] = (short)f2bf(st[2 * sl + 1][j]);
      }
#pragma unroll
      for (int dt = 0; dt < 8; ++dt) {
        const u16* vp = Vt + (dt * 16 + fr) * 264 + sl * 32 + fq * 4;
        u16x4 a0 = *(const u16x4*)vp;
        u16x4 a1 = *(const u16x4*)(vp + 16);
        bf16x8 va;
        va[0] = a0[0]; va[1] = a0[1]; va[2] = a0[2]; va[3] = a0[3];
        va[4] = a1[0]; va[5] = a1[1]; va[6] = a1[2]; va[7] = a1[3];
        oa[dt] = __builtin_amdgcn_mfma_f32_16x16x32_bf16(va, pb, oa[dt], 0, 0, 0);
      }
      __builtin_amdgcn_sched_barrier(0);
    }
    if (q0 + fr < nq) {
#pragma unroll
      for (int dt = 0; dt < 8; ++dt) {
        u16x4 ob;
#pragma unroll
        for (int j = 0; j < 4; ++j) ob[j] = f2bf(oa[dt][j] * inv);
        *(u16x4*)(o + (size_t)(q0 + fr) * ldo + dt * 16 + fq * 4) = ob;
      }
    }
  }
}

__device__ __forceinline__ void attn_phase(const Params& p, int layer, int ldp, char* shm, int wv, int start, int stride) {
  const u16* P = (const u16*)(p.ws + WS_P);
  u16* TM = (u16*)(p.ws + WS_TM);
  for (int it = start; it < 256 + 512; it += stride) {
    if (it < 256) {
      int ch = it & 15, h = (it >> 4) & 3, b = it >> 6;
      int row0 = b * SEQ + ch * 128;
      const float* kb = p.out + O_MK + ((size_t)(layer * 4 + b) * NMEM * 4 + h) * 128;
      const float* vb = p.out + O_MV + ((size_t)(layer * 4 + b) * NMEM * 4 + h) * 128;
      attn_item(P + (size_t)row0 * ldp + h * 128, ldp, 128, kb, vb, TM + (size_t)row0 * D + TOKW + h * 128, D, shm, wv);
    } else {
      int s = it - 256, h = s & 3, b = s >> 2;
      int row0 = MP + b * 8;
      const float* kb = p.cache_k + ((size_t)(layer * 128 + b) * NMEM * 4 + h) * 128;
      const float* vb = p.cache_v + ((size_t)(layer * 128 + b) * NMEM * 4 + h) * 128;
      attn_item(P + (size_t)row0 * ldp + h * 128, ldp, 8, kb, vb, TM + (size_t)row0 * D + TOKW + h * 128, D, shm, wv);
    }
  }
}

__device__ __forceinline__ float red8(float x) {
  x = dpp_add<0xB1>(x);
  x = dpp_add<0x4E>(x);
  x = dpp_add<0x141>(x);
  return x;
}

__device__ __forceinline__ void rwkv_scan_unit(const Params& p, int chain, int rg, bool sample, float* L, int lane) {
  const u16* SR = (const u16*)(p.ws + WS_SCR);
  const u16* SK = (const u16*)(p.ws + WS_SCK);
  const u16* SV = (const u16*)(p.ws + WS_SCV);
  const u16* SKK = (const u16*)(p.ws + WS_SCKK);
  const u16* SB_ = (const u16*)(p.ws + WS_SCB);
  const float* SD = (const float*)(p.ws + WS_LOD);
  float* Y = (float*)(p.ws + WS_Y);
  int b = chain / 24, h = chain - b * 24;
  int row0, T;
  if (sample) { row0 = MP + b * 8; T = 8; } else { row0 = b * SEQ; T = SEQ; }
  const int rl = lane >> 3, kq = lane & 7, row = rg * 8 + rl;
  float S[8];
  if (sample) {
    const float* sp = p.st_rwkv + (((size_t)(b * 24 + h) * 64 + row) * 64 + kq * 8);
    f32x4 s0 = *(const f32x4*)sp, s1 = *(const f32x4*)(sp + 4);
    S[0] = s0[0]; S[1] = s0[1]; S[2] = s0[2]; S[3] = s0[3];
    S[4] = s1[0]; S[5] = s1[1]; S[6] = s1[2]; S[7] = s1[3];
  } else {
#pragma unroll
    for (int i = 0; i < 8; ++i) S[i] = 0.f;
  }
  const size_t hb = (size_t)h * 64;
  const int ss = lane >> 3, cg = (lane & 7) * 8;
  bf16x8 gr0, gk0, gkk0, gb0, gr1, gk1, gkk1, gb1, gr2, gk2, gkk2, gb2;
  f32x4 gda0, gdb0, gda1, gdb1, gda2, gdb2;
  u16 gv0, gv1, gv2;
#define LOADCH(n, t0)                                                                \
  {                                                                                  \
    size_t base = (size_t)(row0 + (t0) + ss) * TOKW + hb + cg;                       \
    gr##n = *(const bf16x8*)(SR + base);                                             \
    gk##n = *(const bf16x8*)(SK + base);                                             \
    gkk##n = *(const bf16x8*)(SKK + base);                                           \
    gb##n = *(const bf16x8*)(SB_ + base);                                            \
    size_t bd = (size_t)(row0 + (t0) + (lane >> 4)) * TOKW + hb + (lane & 15) * 4;   \
    gda##n = *(const f32x4*)(SD + bd);                                               \
    gdb##n = *(const f32x4*)(SD + bd + (size_t)4 * TOKW);                            \
    gv##n = SV[(size_t)(row0 + (t0) + ss) * TOKW + hb + rg * 8 + (lane & 7)];        \
  }
#define ST8(arr, a)                                                                  \
  {                                                                                  \
    f32x4 lo, hi;                                                                    \
    lo[0] = bf2f((u16)arr[0]); lo[1] = bf2f((u16)arr[1]); lo[2] = bf2f((u16)arr[2]); lo[3] = bf2f((u16)arr[3]); \
    hi[0] = bf2f((u16)arr[4]); hi[1] = bf2f((u16)arr[5]); hi[2] = bf2f((u16)arr[6]); hi[3] = bf2f((u16)arr[7]); \
    *(f32x4*)(L + ss * 328 + (a)*64 + cg) = lo;                                      \
    *(f32x4*)(L + ss * 328 + (a)*64 + cg + 4) = hi;                                  \
  }
#define LDSTEP(dst, s)                                                               \
  {                                                                                  \
    const float* Ls = L + (s)*328 + kq * 8;                                          \
    dst[4] = *(const f32x4*)(Ls + 128);                                              \
    dst[5] = *(const f32x4*)(Ls + 132);                                              \
    dst[8] = *(const f32x4*)(Ls + 256);                                              \
    dst[9] = *(const f32x4*)(Ls + 260);                                              \
    dst##v = L[(s)*328 + 320 + rl];                                                  \
  }
#define LDRK(dst, s)                                                                 \
  {                                                                                  \
    const float* Ls = L + (s)*328 + kq * 8;                                          \
    dst[0] = *(const f32x4*)(Ls);                                                    \
    dst[1] = *(const f32x4*)(Ls + 4);                                                \
    dst[2] = *(const f32x4*)(Ls + 64);                                               \
    dst[3] = *(const f32x4*)(Ls + 68);                                               \
    dst[4] = *(const f32x4*)(Ls + 192);                                              \
    dst[5] = *(const f32x4*)(Ls + 196);                                              \
  }
#define STEP(cur, s)                                                                 \
  {                                                                                  \
    LDRK(RK, s);                                                                     \
    float sa = 0.f;                                                                  \
    _Pragma("unroll") for (int i = 0; i < 4; ++i) sa += S[i] * cur[4][i] + S[4 + i] * cur[5][i]; \
    sa = red8(sa);                                                                   \
    float v = cur##v;                                                                \
    float y = 0.f;                                                                   \
    _Pragma("unroll") for (int i = 0; i < 4; ++i) {                                  \
      S[i] = S[i] * cur[8][i] - sa * RK[4][i] + v * RK[2][i];                       \
      S[4 + i] = S[4 + i] * cur[9][i] - sa * RK[5][i] + v * RK[3][i];               \
      y += S[i] * RK[0][i] + S[4 + i] * RK[1][i];                                    \
    }                                                                                \
    ys[s] = red8(y);                                                                 \
  }
#define CHUNK(n, t0)                                                   \
  {                                                                    \
    ST8(gr##n, 0); ST8(gk##n, 1); ST8(gkk##n, 2); ST8(gb##n, 3); \
    *(f32x4*)(L + (lane >> 4) * 328 + 256 + (lane & 15) * 4) = gda##n; \
    *(f32x4*)(L + ((lane >> 4) + 4) * 328 + 256 + (lane & 15) * 4) = gdb##n; \
    L[ss * 328 + 320 + (lane & 7)] = bf2f(gv##n); \
    __builtin_amdgcn_wave_barrier(); \
    if (t0 + 16 < T) { LOADCH(n, t0 + 16); } \
    f32x4 A[10], B[10], RK[6]; \
    float Av, Bv; \
    float ys[8]; \
    __builtin_amdgcn_sched_barrier(0); LDSTEP(A, 0); \
    LDSTEP(B, 1); STEP(A, 0); __builtin_amdgcn_sched_barrier(0); \
    LDSTEP(A, 2); STEP(B, 1); __builtin_amdgcn_sched_barrier(0); \
    LDSTEP(B, 3); STEP(A, 2); __builtin_amdgcn_sched_barrier(0); \
    LDSTEP(A, 4); STEP(B, 3); __builtin_amdgcn_sched_barrier(0); \
    LDSTEP(B, 5); STEP(A, 4); __builtin_amdgcn_sched_barrier(0); \
    LDSTEP(A, 6); STEP(B, 5); __builtin_amdgcn_sched_barrier(0); \
    LDSTEP(B, 7); STEP(A, 6); __builtin_amdgcn_sched_barrier(0); \
    STEP(B, 7); \
    float yo = ys[0]; \
    _Pragma("unroll") for (int s = 1; s < 8; ++s) yo = (kq == s) ? ys[s] : yo; \
    Y[(size_t)(row0 + t0 + kq) * TOKW + hb + row] = yo; \
    __builtin_amdgcn_wave_barrier(); \
  }
  LOADCH(0, 0);
  if (T > 8) { LOADCH(1, 8); }
  for (int tb = 0; tb < T; tb += 16) {
    { const int t0 = tb; CHUNK(0, t0) }
    if (tb + 8 < T) { const int t0 = tb + 8; CHUNK(1, t0) }
  }
#undef CHUNK
#undef LOADCH
#undef ST8
#undef LDSTEP
#undef LDRK
#undef STEP
  float* so = (sample ? p.out + O_RS : p.out + O_RP) + (((size_t)(b * 24 + h) * 64 + row) * 64 + kq * 8);
  *(f32x4*)so = (f32x4){S[0], S[1], S[2], S[3]};
  *(f32x4*)(so + 4) = (f32x4){S[4], S[5], S[6], S[7]};
}

__device__ __forceinline__ void hgrn_seq(const Params& p, int b, int h, bool sample, char* shm, int wv) {
  const u16* P = (const u16*)(p.ws + WS_P);
  float* O = (float*)(p.ws + WS_Y);
  float* lq = (float*)shm;
  float* lf = lq + 1024;
  float* li = lf + 1024;
  float* part = li + 1024;
  int tid = ltid(wv), v = tid & 127, kq = tid >> 7;
  int row0, T;
  if (sample) { row0 = MP + b * 8; T = 8; } else { row0 = b * SEQ; T = SEQ; }
  float S[32];
  if (sample) {
    const float* sp = p.st_hgrn + ((size_t)(b * 12 + h) * 128 + kq * 32) * 128 + v;
#pragma unroll
    for (int i = 0; i < 32; ++i) S[i] = sp[(size_t)i * 128];
  } else {
#pragma unroll
    for (int i = 0; i < 32; ++i) S[i] = 0.f;
  }
  for (int t0 = 0; t0 < T; t0 += 8) {
    __syncthreads();
#pragma unroll
    for (int e = 0; e < 6; ++e) {
      int idx = tid + 512 * e;
      int arr = idx >> 10, s = (idx >> 7) & 7, c = idx & 127;
      float val = bf2f(P[(size_t)(row0 + t0 + s) * BIN_N + MEMW + arr * TOKW + h * 128 + c]);
      if (arr == 1) val = __expf(val);
      lq[idx] = val;
    }
    __syncthreads();
#pragma unroll 1
    for (int s = 0; s < 8; ++s) {
      float vv = li[s * 128 + v];
      float o = 0.f;
      const float* fq_ = lf + s * 128 + kq * 32;
      const float* qq_ = lq + s * 128 + kq * 32;
#pragma unroll
      for (int i4 = 0; i4 < 8; ++i4) {
        f32x4 f4 = *(const f32x4*)(fq_ + i4 * 4);
        f32x4 q4 = *(const f32x4*)(qq_ + i4 * 4);
#pragma unroll
        for (int j = 0; j < 4; ++j) {
          float f = f4[j];
          float sn = f * S[i4 * 4 + j] + (1.f - f) * vv;
          S[i4 * 4 + j] = sn;
          o += q4[j] * sn;
        }
      }
      part[(kq * 8 + s) * 128 + v] = o;
    }
    __syncthreads();
#pragma unroll
    for (int e = 0; e < 2; ++e) {
      int idx = tid + 512 * e;
      int s = idx >> 7, c = idx & 127;
      float o = part[idx] + part[1024 + idx] + part[2048 + idx] + part[3072 + idx];
      O[(size_t)(row0 + t0 + s) * TOKW + h * 128 + c] = o;
    }
  }
  float* so = (sample ? p.out + O_HS : p.out + O_HP) + ((size_t)(b * 12 + h) * 128 + kq * 32) * 128 + v;
#pragma unroll
  for (int i = 0; i < 32; ++i) {
    *so = S[i];
    so += 128;
    asm volatile("" : "+v"(so));
  }
}


__device__ __forceinline__ float fast_sigmoid(float x) { return __builtin_amdgcn_rcpf(1.f + __expf(-x)); }

__device__ __forceinline__ void hgrn_prompt_mfma(const Params& p, int b, int h, char* shm, int wv) {
  const u16* P = (const u16*)(p.ws + WS_P);
  float* O = (float*)(p.ws + WS_Y);
  u16* Qe = (u16*)shm;
  u16* Kd = Qe + 64 * 136;
  u16* Kdt = Kd + 64 * 136;
  u16* Vt = Kdt + 128 * 72;
  u16* Pt = Vt + 128 * 72;
  u16* St = Pt + 64 * 72;
  float* tot = (float*)(St + 128 * 136);
  float* eb = tot + 1024;
  float* ssq = eb + 128;
  const int tid = ltid(wv), lane = tid & 63, w = wv;
  const int fr = lane & 15, fq = lane >> 4;
  const int c0 = lane * 2;
  const int row0 = b * SEQ;
  float lb0, lb1;
  {
    int cc = h * 128 + c0;
    lb0 = 1.f / (1.f + __expf(p.b_lb[cc] - p.b_lb[TOKW + cc]));
    lb1 = 1.f / (1.f + __expf(p.b_lb[cc + 1] - p.b_lb[TOKW + cc + 1]));
  }
  unsigned rq[8], rf[8], ri[8];
#define LOADRAW(t0)                                                                        \
  _Pragma("unroll") for (int i = 0; i < 8; ++i) {                                          \
    const u16* bp = P + (size_t)(row0 + (t0) + w * 8 + i) * BIN_N + MEMW + h * 128 + c0;   \
    rq[i] = *(const unsigned*)(bp);                                                        \
    rf[i] = *(const unsigned*)(bp + TOKW);                                                 \
    ri[i] = *(const unsigned*)(bp + 2 * TOKW);                                             \
  }
  f32x4 S[8];
#pragma unroll
  for (int i = 0; i < 8; ++i) S[i] = (f32x4){0.f, 0.f, 0.f, 0.f};
  const f32x4 gn4 = *(const f32x4*)(p.b_g_norm + w * 16 + fq * 4);
  u16* TMo = (u16*)(p.ws + WS_TM);
  LOADRAW(0);
  __syncthreads();
#pragma unroll 1
  for (int chunk = 0; chunk < 32; ++chunk) {
    const int t0 = chunk * 64;
    float qs0[8], qs1[8], om0[8], om1[8], cs0[8], cs1[8];
    float run0 = 0.f, run1 = 0.f;
    bf16x8 v0, v1;
#pragma unroll
    for (int i = 0; i < 8; ++i) {
      float q0 = __uint_as_float(rq[i] << 16), q1 = __uint_as_float(rq[i] & 0xffff0000u);
      float f0 = __uint_as_float(rf[i] << 16), f1 = __uint_as_float(rf[i] & 0xffff0000u);
      qs0[i] = q0;
      qs1[i] = q1;
      float g0 = __expf(f0);
      float g1 = __expf(f1);
      run0 += f0; run1 += f1;
      cs0[i] = run0; cs1[i] = run1;
      om0[i] = 1.f - g0; om1[i] = 1.f - g1;
      v0[i] = (short)(ri[i] & 0xffffu);
      v1[i] = (short)(ri[i] >> 16);
    }
    tot[w * 128 + c0] = run0;
    tot[w * 128 + c0 + 1] = run1;
    *(bf16x8*)(Vt + c0 * 72 + w * 8) = v0;
    *(bf16x8*)(Vt + (c0 + 1) * 72 + w * 8) = v1;
    __syncthreads();
    float pre0 = 0.f, pre1 = 0.f, bl0 = 0.f, bl1 = 0.f;
#pragma unroll
    for (int ww = 0; ww < 8; ++ww) {
      float a0 = tot[ww * 128 + c0], a1 = tot[ww * 128 + c0 + 1];
      if (ww < w) { pre0 += a0; pre1 += a1; }
      bl0 += a0; bl1 += a1;
    }
    bf16x8 kt0, kt1;
#pragma unroll
    for (int i = 0; i < 8; ++i) {
      float bc0 = pre0 + cs0[i], bc1 = pre1 + cs1[i];
      float qe0 = qs0[i] * __expf(bc0), qe1 = qs1[i] * __expf(bc1);
      float kd0 = om0[i] * __expf(-bc0), kd1 = om1[i] * __expf(-bc1);
      u16 k0b = f2bf(kd0), k1b = f2bf(kd1);
      *(unsigned*)(Qe + (w * 8 + i) * 136 + c0) = (unsigned)f2bf(qe0) | ((unsigned)f2bf(qe1) << 16);
      *(unsigned*)(Kd + (w * 8 + i) * 136 + c0) = (unsigned)k0b | ((unsigned)k1b << 16);
      kt0[i] = (short)k0b; kt1[i] = (short)k1b;
    }
    *(bf16x8*)(Kdt + c0 * 72 + w * 8) = kt0;
    *(bf16x8*)(Kdt + (c0 + 1) * 72 + w * 8) = kt1;
    if (w == 0) { eb[c0] = __expf(bl0); eb[c0 + 1] = __expf(bl1); }
    __syncthreads();
    if (chunk + 1 < 32) { LOADRAW(t0 + 64); }
#pragma unroll
    for (int e = 0; e < 2; ++e) {
      int id = w * 2 + e, st = id >> 2, tt = id & 3;
      u16x4 outv = {0, 0, 0, 0};
      if (st <= tt) {
        f32x4 a = {0.f, 0.f, 0.f, 0.f};
#pragma unroll
        for (int ks = 0; ks < 4; ++ks) {
          bf16x8 ka = *(const bf16x8*)(Kd + (st * 16 + fr) * 136 + ks * 32 + fq * 8);
          bf16x8 qb = *(const bf16x8*)(Qe + (tt * 16 + fr) * 136 + ks * 32 + fq * 8);
          a = __builtin_amdgcn_mfma_f32_16x16x32_bf16(ka, qb, a, 0, 0, 0);
        }
#pragma unroll
        for (int j = 0; j < 4; ++j) {
          float val = a[j];
          if (st == tt && fq * 4 + j > fr) val = 0.f;
          outv[j] = f2bf(val);
        }
      }
      *(u16x4*)(Pt + (tt * 16 + fr) * 72 + st * 16 + fq * 4) = outv;
    }
    __syncthreads();
    f32x4 oa[4];
#pragma unroll
    for (int tt = 0; tt < 4; ++tt) oa[tt] = (f32x4){0.f, 0.f, 0.f, 0.f};
#pragma unroll
    for (int sl = 0; sl < 2; ++sl) {
      bf16x8 va = *(const bf16x8*)(Vt + (w * 16 + fr) * 72 + sl * 32 + fq * 8);
#pragma unroll
      for (int tt = 0; tt < 4; ++tt) {
        bf16x8 pb = *(const bf16x8*)(Pt + (tt * 16 + fr) * 72 + sl * 32 + fq * 8);
        oa[tt] = __builtin_amdgcn_mfma_f32_16x16x32_bf16(va, pb, oa[tt], 0, 0, 0);
      }
    }
    if (chunk > 0) {
#pragma unroll
      for (int ks = 0; ks < 4; ++ks) {
        bf16x8 sa = *(const bf16x8*)(St + (w * 16 + fr) * 136 + ks * 32 + fq * 8);
#pragma unroll
        for (int tt = 0; tt < 4; ++tt) {
          bf16x8 qb = *(const bf16x8*)(Qe + (tt * 16 + fr) * 136 + ks * 32 + fq * 8);
          oa[tt] = __builtin_amdgcn_mfma_f32_16x16x32_bf16(sa, qb, oa[tt], 0, 0, 0);
        }
      }
    }
    u16x4 og4[4];
#pragma unroll
    for (int tt = 0; tt < 4; ++tt) {
      og4[tt] = *(const u16x4*)(P + (size_t)(row0 + t0 + tt * 16 + fr) * BIN_N + MEMW + 3 * TOKW + h * 128 + w * 16 + fq * 4);
      float s = oa[tt][0] * oa[tt][0] + oa[tt][1] * oa[tt][1] + oa[tt][2] * oa[tt][2] + oa[tt][3] * oa[tt][3];
      s += __int_as_float(__builtin_amdgcn_ds_bpermute((lane ^ 16) << 2, __float_as_int(s)));
      s += __int_as_float(__builtin_amdgcn_ds_bpermute((lane ^ 32) << 2, __float_as_int(s)));
      if (fq == 0) ssq[w * 64 + tt * 16 + fr] = s;
    }
#pragma unroll
    for (int sl = 0; sl < 2; ++sl) {
      bf16x8 ka = *(const bf16x8*)(Kdt + (w * 16 + fr) * 72 + sl * 32 + fq * 8);
#pragma unroll
      for (int vt = 0; vt < 8; ++vt) {
        bf16x8 vb = *(const bf16x8*)(Vt + (vt * 16 + fr) * 72 + sl * 32 + fq * 8);
        S[vt] = __builtin_amdgcn_mfma_f32_16x16x32_bf16(ka, vb, S[vt], 0, 0, 0);
      }
    }
    {
      f32x4 e4 = *(const f32x4*)(eb + w * 16 + fq * 4);
#pragma unroll
      for (int vt = 0; vt < 8; ++vt) S[vt] *= e4;
    }
    __syncthreads();
#pragma unroll
    for (int tt = 0; tt < 4; ++tt) {
      float tot_ss = 0.f;
#pragma unroll
      for (int ww = 0; ww < 8; ++ww) tot_ss += ssq[ww * 64 + tt * 16 + fr];
      const float sc = rsqrtf(tot_ss * (1.f / 128.f) + 1e-6f);
      u16x4 ob;
#pragma unroll
      for (int j = 0; j < 4; ++j) {
        float g = bf2f(og4[tt][j]);
        ob[j] = f2bf(oa[tt][j] * sc * gn4[j] * (g * __builtin_amdgcn_rcpf(1.f + __expf(-g))));
      }
      *(u16x4*)(TMo + (size_t)(row0 + t0 + tt * 16 + fr) * D + h * 128 + w * 16 + fq * 4) = ob;
    }
#pragma unroll
    for (int vt = 0; vt < 8; ++vt) {
      u16x4 o;
      o[0] = f2bf(S[vt][0]); o[1] = f2bf(S[vt][1]); o[2] = f2bf(S[vt][2]); o[3] = f2bf(S[vt][3]);
      *(u16x4*)(St + (vt * 16 + fr) * 136 + w * 16 + fq * 4) = o;
    }
  }
#undef LOADRAW
  float* so = p.out + O_HP + (size_t)(b * 12 + h) * 128 * 128;
#pragma unroll
  for (int vt = 0; vt < 8; ++vt)
#pragma unroll
    for (int j = 0; j < 4; ++j) so[(size_t)(w * 16 + fq * 4 + j) * 128 + vt * 16 + fr] = S[vt][j];
  __syncthreads();
}

__device__ __forceinline__ void gemm_phase(int ph, char* shm, int wv) {
  const int T2 = (MA0 / BM) * (AIN_NP / BM);
  int total;
  if (ph == 1) total = T2 + 32;
  else if (ph == 3) total = (MT / BM) * (LORA_N / BM);
  else if (ph == 9 || ph == 17) total = 37 * (DFF2 / BM);
  else if (ph == 13) total = (MT / BM) * (BIN_N / BM);
  else total = 256 + 128;
  for (int t = blockIdx.x; t < total; t += gridDim.x) {
    char* ws;
    {
      Params p2;
      load_params(p2);
      ws = p2.ws;
    }
    const u16* A; const u16* Bt; int M, N, K;
    int lt = t;
    int nt = 32;
    if (ph == 1) {
      if (t < T2) {
        A = (const u16*)(ws + WS_H); Bt = (const u16*)(ws + WS_AIN); M = MA0; N = AIN_NP; K = D;
      } else {
        int l = (t - T2) >> 4; lt = (t - T2) & 15;
        A = (const u16*)(ws + WS_MH) + (size_t)l * 1024 * D; Bt = (const u16*)(ws + WS_KV) + (size_t)l * 1024 * D;
        M = 1024; N = 1024; K = D;
      }
    } else if (ph == 3) {
      A = (const u16*)(ws + WS_LA); Bt = (const u16*)(ws + WS_LORA); M = MT; N = LORA_N; K = LORA_K;
      {
        const int nN_ = LORA_N / BM, nM_ = MT / BM, nwg_ = nM_ * nN_;
        int w_ = t;
        { int q = nwg_ / NXCD, r = nwg_ % NXCD, xcd = w_ % NXCD, off = w_ / NXCD; w_ = (xcd < r ? xcd * (q + 1) : r * (q + 1) + (xcd - r) * q) + off; }
        int nig_ = WGM * nN_, gid_ = w_ / nig_, fm_ = gid_ * WGM, gsz_ = min(nM_ - fm_, WGM);
        int pn_ = (w_ % nig_) / gsz_;
        int blk_ = (pn_ * BM) / TOKW;
        int kofs = blk_ == 0 ? 0 : (blk_ == 1 ? 64 : 192);
        nt = blk_ == 2 ? 4 : 2;
        A += kofs; Bt += kofs;
      }
    } else if (ph == 7 || ph == 15) {
      A = (const u16*)(ws + WS_TM); Bt = (const u16*)(ws + (ph == 7 ? WS_AOUT : WS_BOUT)); M = MT; N = D; K = D;
      if (t >= 256) { const int j = t - 256; lt = 256 + (j >> 2); nt = 8; A += (j & 3) * 8 * BK; Bt += (j & 3) * 8 * BK; }
    } else if (ph == 9 || ph == 17) {
      int layer = ph == 9 ? 0 : 1;
      A = (const u16*)(ws + WS_H); Bt = (const u16*)(ws + WS_UP) + (size_t)layer * DFF2 * D; M = 37 * BM; N = DFF2; K = D;
    } else if (ph == 11 || ph == 19) {
      int layer = ph == 11 ? 0 : 1;
      A = (const u16*)(ws + WS_U); Bt = (const u16*)(ws + WS_DN) + (size_t)layer * D * DFF; M = MT; N = D; K = DFF; nt = DFF / BK;
      if (t >= 256) { const int j = t - 256; lt = 256 + (j >> 2); nt = 22; A += (j & 3) * 22 * BK; Bt += (j & 3) * 22 * BK; }
    } else {
      A = (const u16*)(ws + WS_H); Bt = (const u16*)(ws + WS_BIN); M = MT; N = BIN_N; K = D;
    }
    gemm_tile(A, Bt, M, N, K, lt, ph, t, (u16*)shm, wv, nt);
  }
  {
    int r0 = -1;
    if (ph == 9) r0 = 92;
    else if (ph == 11) r0 = 128;
    else if (ph == 13) r0 = 168;
    if (r0 >= 0 && (int)blockIdx.x >= r0) {
      Params p2;
      load_params(p2);
      char* ws = p2.ws;
      float* tile = (float*)shm;
      const int st = blockIdx.x - r0;
      int g = (int)gridDim.x - r0;
      asm volatile("" : "+s"(g));
      __syncthreads();
      if (ph == 9) {
        transpose_job(p2.b_w_in, D, BIN_N, BIN_N, (u16*)(ws + WS_BIN), tile, st, g, wv, p2.norm_mix + D);
        transpose_job(p2.b_w_out, D, D, D, (u16*)(ws + WS_BOUT), tile, (st + 64) % g, g, wv);
        transpose_job(p2.ffn_w_down, DFF, D, D, (u16*)(ws + WS_DN), tile, (st + 100) % g, g, wv);
      } else if (ph == 11) {
        transpose_job(p2.ffn_w_up + (size_t)D * DFF2, D, DFF2, DFF2, (u16*)(ws + WS_UP) + (size_t)DFF2 * D, tile, st, g, wv, p2.norm_ffn + D, 1);
      } else {
        transpose_job(p2.ffn_w_down + (size_t)DFF * D, DFF, D, D, (u16*)(ws + WS_DN) + (size_t)D * DFF, tile, st, g, wv);
      }
    }
  }
}

constexpr int NPHASE = 17;

__device__ __forceinline__ void run_phase(const Params& p, int ph, char* shm, int wv) {
#define PH_TID const int tid = ltid(wv), lane = tid & 63, wid = tid >> 6; const int gw = blockIdx.x * 8 + wid, nw = gridDim.x * 8; (void)tid; (void)lane; (void)gw; (void)nw;
#define GTID ((size_t)blockIdx.x * NTHREADS + tid)
#define GTHREADS ((size_t)gridDim.x * NTHREADS)
  char* ws = p.ws;
  u16* H = (u16*)(ws + WS_H);
  u16* PB = (u16*)(ws + WS_P);
  float* X = (float*)(ws + WS_X);
  u16* TM = (u16*)(ws + WS_TM);
  switch (ph) {
    case 0: {
      PH_TID
      float* tile = (float*)shm;
      {
        const int g = gridDim.x, bx = blockIdx.x;
        transpose_job(p.a_w_in, D, AIN_N, AIN_NP, (u16*)(ws + WS_AIN), tile, bx, g, wv);
        transpose_job(p.w_mem_kv, D, 1024, 1024, (u16*)(ws + WS_KV), tile, (bx + 40) % g, g, wv);
        transpose_job(p.w_mem_kv + (size_t)D * 1024, D, 1024, 1024, (u16*)(ws + WS_KV) + (size_t)1024 * D, tile, (bx + 80) % g, g, wv);
        transpose_job(p.a_w_out, D, D, D, (u16*)(ws + WS_AOUT), tile, (bx + 160) % g, g, wv);
      }
      for (size_t i = GTID; i < (size_t)3 * MT; i += GTHREADS) ((float*)(ws + WS_SS))[i] = 0.f;
      for (size_t i = GTID; i < 4 * 32; i += GTHREADS) ((int*)(ws + WS_FLAG))[i] = 0;
      u16* WL = (u16*)(ws + WS_LORA);
      for (size_t i = GTID; i < (size_t)LORA_N * LORA_K; i += GTHREADS) {
        int n = (int)(i >> 9), k = (int)(i & 511);
        float v = 0.f;
        if (n < TOKW) { if (k < 96) v = p.a_w2[(size_t)k * TOKW + n]; }
        else if (n < 2 * TOKW) { if (k >= 96 && k < 192) v = p.a_a2[(size_t)(k - 96) * TOKW + (n - TOKW)]; }
        else { if (k >= 192 && k < 448) v = p.a_g2[(size_t)(k - 192) * TOKW + (n - 2 * TOKW)]; }
        WL[i] = f2bf(v);
      }
      for (int r = gw; r < MA0 + 2048; r += nw) {
        if (r < MT) {
          const float* src = r < MP ? p.x_prompt + (size_t)r * D : p.x_sample + (size_t)(r - MP) * D;
          float* df = nullptr;
          if (r < MP) { if ((r & (SEQ - 1)) == SEQ - 1) df = p.out + O_SP + (size_t)(r >> 11) * D; }
          else { int s = r - MP; if ((s & 7) == 7) df = p.out + O_SS + (size_t)(s >> 3) * D; }
          norm_row_wave(src, p.norm_mix, H + (size_t)r * D, df, lane);
        } else if (r < MT + 128) {
          const float* src = p.st_shift + (size_t)(r - MT) * D;
#pragma unroll
          for (int i = 0; i < 8; ++i) {
            f32x4 v = ((const f32x4*)src)[lane + 64 * i];
            u16x4 ob; ob[0] = f2bf(v[0]); ob[1] = f2bf(v[1]); ob[2] = f2bf(v[2]); ob[3] = f2bf(v[3]);
            ((u16x4*)(H + (size_t)r * D))[lane + 64 * i] = ob;
          }
        } else if (r < MA0) {
          u16x4 z = {0, 0, 0, 0};
#pragma unroll
          for (int i = 0; i < 8; ++i) ((u16x4*)(H + (size_t)r * D))[lane + 64 * i] = z;
        } else {
          int m = r - MA0, l = m >> 10, mr = m & 1023;
          norm_row_wave(p.mem_prompt + (size_t)mr * D, p.mem_norm + (size_t)l * D,
                        (u16*)(ws + WS_MH) + (size_t)m * D, nullptr, lane);
        }
      }
    } break;

    case 2: {
      PH_TID
      u16* LA = (u16*)(ws + WS_LA);
      for (size_t i = GTID; i < (size_t)MT * 64; i += GTHREADS) {
        const int row = (int)(i >> 6), j8 = (int)(i & 63) * 8;
        bf16x8 ob;
        if (j8 < 448) {
          const int col = MEMW + 4608 + j8;
          const bf16x8 pc = *(const bf16x8*)(PB + (size_t)row * AIN_NP + col);
          const int pr = prev_row(row);
          bf16x8 pp = {0, 0, 0, 0, 0, 0, 0, 0};
          if (pr >= 0) pp = *(const bf16x8*)(PB + (size_t)pr * AIN_NP + col);
          const f32x4 m0 = *(const f32x4*)(p.a_mu + 4608 + j8), m1 = *(const f32x4*)(p.a_mu + 4608 + j8 + 4);
#pragma unroll
          for (int e = 0; e < 8; ++e) {
            float c = bf2f((u16)pc[e]), q = bf2f((u16)pp[e]);
            float mu = e < 4 ? m0[e & 3] : m1[e & 3];
            float xm = c + mu * (q - c);
            float val;
            if (j8 < 96) val = 1.f - 2.f * __builtin_amdgcn_rcpf(1.f + __expf(2.f * xm));
            else if (j8 < 192) val = xm;
            else val = __builtin_amdgcn_rcpf(1.f + __expf(-xm));
            ob[e] = (short)f2bf(val);
          }
        } else {
          ob = (bf16x8){0, 0, 0, 0, 0, 0, 0, 0};
        }
        *(bf16x8*)(LA + (size_t)row * LORA_K + j8) = ob;
      }
    } break;

    case 4: {
      PH_TID
      const u16* LOA = (const u16*)(ws + WS_LOA);
      u16 *SR = (u16*)(ws + WS_SCR), *SK = (u16*)(ws + WS_SCK), *SV = (u16*)(ws + WS_SCV), *SKK = (u16*)(ws + WS_SCKK),
          *SBB = (u16*)(ws + WS_SCB);
      float* BONS = (float*)(ws + WS_BONS);
      const int hl = lane >> 5, l2 = (lane & 31) * 2;
      const int nseg = nw / 12, hp = gw % 12, seg = gw / 12;
      if (seg < nseg) {
        const int rps = (MT + nseg - 1) / nseg;
        const int rbeg = seg * rps, rend = min(rbeg + rps, MT);
        const int h = hp * 2 + hl, c = h * 64 + l2;
        const float2 mur = *(const float2*)(p.a_mu + c), muk = *(const float2*)(p.a_mu + TOKW + c), muv = *(const float2*)(p.a_mu + 2 * TOKW + c);
        const float2 kkw = *(const float2*)(p.a_k_k + c), kaw = *(const float2*)(p.a_k_a + c), rkw = *(const float2*)(p.a_r_k + c);
        const u16* pcb = PB + MEMW + c;
        unsigned pr_ = 0, pk_ = 0, pv_ = 0;
        unsigned nr = 0, nk = 0, nv = 0, na = 0;
        if (rbeg < rend) {
          const u16* q_ = pcb + (size_t)rbeg * AIN_NP;
          nr = *(const unsigned*)q_; nk = *(const unsigned*)(q_ + TOKW); nv = *(const unsigned*)(q_ + 2 * TOKW);
          na = *(const unsigned*)(LOA + (size_t)rbeg * TOKW + c);
          int pr = prev_row(rbeg);
          if (pr >= 0) { const u16* pp_ = pcb + (size_t)pr * AIN_NP; pr_ = *(const unsigned*)pp_; pk_ = *(const unsigned*)(pp_ + TOKW); pv_ = *(const unsigned*)(pp_ + 2 * TOKW); }
        }
        for (int row = rbeg; row < rend; ++row) {
          const unsigned ur = nr, uk = nk, uv = nv, ua = na;
          if (row + 1 < rend) {
            const u16* q_ = pcb + (size_t)(row + 1) * AIN_NP;
            nr = *(const unsigned*)q_; nk = *(const unsigned*)(q_ + TOKW); nv = *(const unsigned*)(q_ + 2 * TOKW);
            na = *(const unsigned*)(LOA + (size_t)(row + 1) * TOKW + c);
          }
          float r0 = bflo(ur), r1 = bfhi(ur), k0 = bflo(uk), k1 = bfhi(uk), v0 = bflo(uv), v1 = bfhi(uv);
          r0 += mur.x * (bflo(pr_) - r0); r1 += mur.y * (bfhi(pr_) - r1);
          k0 += muk.x * (bflo(pk_) - k0); k1 += muk.y * (bfhi(pk_) - k1);
          v0 += muv.x * (bflo(pv_) - v0); v1 += muv.y * (bfhi(pv_) - v1);
          {
            int prn = prev_row(row + 1);
            if (prn == row) { pr_ = ur; pk_ = uk; pv_ = uv; }
            else if (prn < 0) { pr_ = 0; pk_ = 0; pv_ = 0; }
            else if (row + 1 < rend) { const u16* pp_ = pcb + (size_t)prn * AIN_NP; pr_ = *(const unsigned*)pp_; pk_ = *(const unsigned*)(pp_ + TOKW); pv_ = *(const unsigned*)(pp_ + 2 * TOKW); }
          }
          float a0 = bflo(ua), a1 = bfhi(ua);
          float kk0 = k0 * kkw.x, kk1 = k1 * kkw.y;
          float ss = half_sum(kk0 * kk0 + kk1 * kk1);
          float rn = rsqrtf(fmaxf(ss, 1e-24f));
          kk0 *= rn; kk1 *= rn;
          float k20 = k0 * (1.f + (a0 - 1.f) * kaw.x), k21 = k1 * (1.f + (a1 - 1.f) * kaw.y);
          float bon = half_sum(r0 * k20 * rkw.x + r1 * k21 * rkw.y);
          size_t o = (size_t)row * TOKW + c;
          *(unsigned*)(SR + o) = pack2(r0, r1);
          *(unsigned*)(SK + o) = pack2(k20, k21);
          *(unsigned*)(SV + o) = pack2(v0, v1);
          *(unsigned*)(SKK + o) = pack2(kk0, kk1);
          *(unsigned*)(SBB + o) = pack2(kk0 * a0, kk1 * a1);
          if ((lane & 31) == 0) BONS[(size_t)row * 24 + h] = bon;
        }
      }
    } break;
    case 5: {
      PH_TID
      const int NSB = 192;
      const int lane5 = ltid(wv) & 63;
      float* L = (float*)shm + wv * (8 * 328);
      const int NSU = 3072 * 8;
      if ((int)blockIdx.x < NSB) {
        if (wv < 4) {
          int u = blockIdx.x * 4 + wv;
          if (u < 768) rwkv_scan_unit(p, u >> 3, u & 7, false, L, lane5);
        } else {
          for (int u = blockIdx.x * 4 + (wv - 4); u < 15360; u += NSB * 4) rwkv_scan_unit(p, u >> 3, u & 7, true, L, lane5);
        }
      } else {
        int nb_ = (int)gridDim.x - NSB; asm volatile("" : "+s"(nb_));
        attn_phase(p, 0, AIN_NP, shm, wv, blockIdx.x - NSB, nb_);
        __syncthreads();
        for (int u = 15360 + ((int)blockIdx.x - NSB) * 8 + wv; u < NSU; u += nb_ * 8) rwkv_scan_unit(p, u >> 3, u & 7, true, L, lane5);
        __syncthreads();
        transpose_job(p.ffn_w_up, D, DFF2, DFF2, (u16*)(ws + WS_UP), (float*)shm, blockIdx.x - NSB, nb_, wv, p.norm_ffn, 1);
      }
    } break;
    case 6: {
      PH_TID
      const float* Y = (const float*)(ws + WS_Y);
      const u16* SV = (const u16*)(ws + WS_SCV);
      const u16* LOG_ = (const u16*)(ws + WS_LOG);
      const float* BONS = (const float*)(ws + WS_BONS);
      const int hl = lane >> 5, l2 = (lane & 31) * 2;
      const int nseg = nw / 12, hp = gw % 12, seg = gw / 12;
      if (seg < nseg) {
        const int rps = (MT + nseg - 1) / nseg;
        const int rbeg = seg * rps, rend = min(rbeg + rps, MT);
        const int h = hp * 2 + hl, c = h * 64 + l2;
        const float2 lw = *(const float2*)(p.a_ln_w + c), lbb = *(const float2*)(p.a_ln_b + c);
        float2 ny = {0.f, 0.f}; unsigned nv = 0, ng = 0; float nb = 0.f;
        if (rbeg < rend) {
          size_t o = (size_t)rbeg * TOKW + c;
          ny = *(const float2*)(Y + o); nv = *(const unsigned*)(SV + o); ng = *(const unsigned*)(LOG_ + o); nb = BONS[(size_t)rbeg * 24 + h];
        }
        for (int row = rbeg; row < rend; ++row) {
          const float2 y = ny; const unsigned uv = nv, ug = ng; const float bs = nb;
          if (row + 1 < rend) {
            size_t o = (size_t)(row + 1) * TOKW + c;
            ny = *(const float2*)(Y + o); nv = *(const unsigned*)(SV + o); ng = *(const unsigned*)(LOG_ + o); nb = BONS[(size_t)(row + 1) * 24 + h];
          }
          float mu = half_sum(y.x + y.y) * (1.f / 64.f);
          float d0 = y.x - mu, d1 = y.y - mu;
          float var = half_sum(d0 * d0 + d1 * d1) * (1.f / 64.f);
          float rs = rsqrtf(var + 64e-5f);
          float o0 = (d0 * rs * lw.x + lbb.x + bs * bflo(uv)) * bflo(ug);
          float o1 = (d1 * rs * lw.y + lbb.y + bs * bfhi(uv)) * bfhi(ug);
          *(unsigned*)(TM + (size_t)row * D + c) = pack2(o0, o1);
        }
      }
    } break;

    case 8: case 16: {
      PH_TID
      int layer = ph == 8 ? 0 : 1;
      norm_tokens(X, X + (size_t)MP * D, p.norm_ffn + (size_t)layer * D, H, nullptr, nullptr, wv);
    } break;

    case 10: case 18: {
      PH_TID
      int layer = ph == 10 ? 0 : 1;
      const u16* AV = (const u16*)(ws + WS_AV);
      u16* U = (u16*)(ws + WS_U);
      const float* cw = p.ffn_conv_w + (size_t)layer * 3 * DFF;
      const float* cb = p.ffn_conv_b + (size_t)layer * DFF;
      const float* sc = p.st_conv + (size_t)layer * 128 * 2 * DFF;
      const int NCG = DFF / 8;
      for (size_t i = GTID; i < (size_t)(MT / 8) * NCG; i += GTHREADS) {
        int rg = (int)(i / NCG), c = (int)(i % NCG) * 8;
        int row0 = rg * 8;
        bool smp = row0 >= MP;
        int t0 = smp ? 0 : (row0 & (SEQ - 1));
        float w0[8], w1[8], w2[8], bb[8], am1[8], am2[8];
#pragma unroll
        for (int j = 0; j < 8; ++j) {
          w0[j] = cw[c + j]; w1[j] = cw[DFF + c + j]; w2[j] = cw[2 * DFF + c + j]; bb[j] = cb[c + j];
          am1[j] = 0.f; am2[j] = 0.f;
        }
        if (smp) {
          int b = (row0 - MP) >> 3;
#pragma unroll
          for (int j = 0; j < 8; ++j) { am2[j] = sc[((size_t)b * 2 + 0) * DFF + c + j]; am1[j] = sc[((size_t)b * 2 + 1) * DFF + c + j]; }
        } else if (t0 > 0) {
          int rm1 = row0 - 1, rm2 = row0 - 2;
          asm volatile("" : "+v"(rm1), "+v"(rm2));
          bf16x8 x1 = *(const bf16x8*)(AV + (size_t)rm1 * DFF2 + c);
          bf16x8 x2 = *(const bf16x8*)(AV + (size_t)rm2 * DFF2 + c);
#pragma unroll
          for (int j = 0; j < 8; ++j) { am1[j] = bf2f((u16)x1[j]); am2[j] = bf2f((u16)x2[j]); }
        }
#pragma unroll
        for (int r = 0; r < 8; ++r) {
          bf16x8 xa = *(const bf16x8*)(AV + (size_t)(row0 + r) * DFF2 + c);
          bf16x8 xv = *(const bf16x8*)(AV + (size_t)(row0 + r) * DFF2 + DFF + c);
          bf16x8 ob;
#pragma unroll
          for (int j = 0; j < 8; ++j) {
            float a = bf2f((u16)xa[j]);
            float cv = bb[j] + am2[j] * w0[j] + am1[j] * w1[j] + a * w2[j];
            float u2 = 1.5957691216057308f * (cv + 0.044715f * cv * cv * cv);
            float g = cv * __builtin_amdgcn_rcpf(1.f + __expf(-u2));
            ob[j] = (short)f2bf(g * bf2f((u16)xv[j]));
            am2[j] = am1[j]; am1[j] = a;
          }
          *(bf16x8*)(U + (size_t)(row0 + r) * DFF + c) = ob;
        }
      }
    } break;

    case 12: {
      PH_TID
      norm_tokens(X, X + (size_t)MP * D, p.norm_mix + D, H, nullptr, nullptr, wv);
    } break;

    case 14: {
      PH_TID
      if (blockIdx.x < 48) {
        hgrn_prompt_mfma(p, blockIdx.x / 12, blockIdx.x % 12, shm, wv);
      } else {
        int nb_ = (int)gridDim.x - 48; asm volatile("" : "+s"(nb_));
        for (int c = blockIdx.x - 48; c < 128 * 12; c += nb_) hgrn_seq(p, c / 12, c % 12, true, shm, wv);
        __syncthreads();
        attn_phase(p, 1, BIN_N, shm, wv, blockIdx.x - 48, nb_);
      }
    } break;
    case 20: {
      PH_TID
      const float* O = (const float*)(ws + WS_Y);
      const int nseg = nw / 12, h = gw % 12, seg = gw / 12;
      if (seg < nseg) {
        const int rps = (MS + nseg - 1) / nseg;
        const int rbeg = MP + seg * rps, rend = min(rbeg + rps, MT);
        const int c0 = h * 128 + lane * 2;
        const float gn0 = p.b_g_norm[lane * 2], gn1 = p.b_g_norm[lane * 2 + 1];
        float2 no = {0.f, 0.f}; unsigned ng = 0;
        if (rbeg < rend) { no = *(const float2*)(O + (size_t)rbeg * TOKW + c0); ng = *(const unsigned*)(PB + (size_t)rbeg * BIN_N + MEMW + 3 * TOKW + c0); }
        for (int row = rbeg; row < rend; ++row) {
          const float2 o = no; const unsigned ug = ng;
          if (row + 1 < rend) { no = *(const float2*)(O + (size_t)(row + 1) * TOKW + c0); ng = *(const unsigned*)(PB + (size_t)(row + 1) * BIN_N + MEMW + 3 * TOKW + c0); }
          float ss = wave_sum(o.x * o.x + o.y * o.y);
          float sc = rsqrtf(ss * (1.f / 128.f) + 1e-6f);
          float g0 = bflo(ug), g1 = bfhi(ug);
          float r0 = o.x * sc * gn0 * (g0 * sigmoidf_(g0));
          float r1 = o.y * sc * gn1 * (g1 * sigmoidf_(g1));
          *(unsigned*)(TM + (size_t)row * D + c0) = pack2(r0, r1);
        }
      }
    } break;
    case 21: {
      PH_TID
      for (int row = gw; row < MT; row += 2 * nw) {
        const int row2 = row + nw;
        const bool has2 = row2 < MT;
        const float* s1 = X + (size_t)row * D;
        const float* s2 = X + (size_t)(has2 ? row2 : row) * D;
        f32x4 v[8], u[8];
        float ss1 = 0.f, ss2 = 0.f;
#pragma unroll
        for (int i = 0; i < 8; ++i) { v[i] = ((const f32x4*)s1)[lane + 64 * i]; u[i] = ((const f32x4*)s2)[lane + 64 * i]; }
#pragma unroll
        for (int i = 0; i < 8; ++i) {
          ss1 += v[i][0] * v[i][0] + v[i][1] * v[i][1] + v[i][2] * v[i][2] + v[i][3] * v[i][3];
          ss2 += u[i][0] * u[i][0] + u[i][1] * u[i][1] + u[i][2] * u[i][2] + u[i][3] * u[i][3];
        }
        ss1 = wave_sum(ss1); ss2 = wave_sum(ss2);
        const float sc1 = rsqrtf(ss1 * (1.f / 2048.f) + 1e-6f), sc2 = rsqrtf(ss2 * (1.f / 2048.f) + 1e-6f);
        float* d1 = row < MP ? p.out + O_YP + (size_t)row * D : p.out + O_YS + (size_t)(row - MP) * D;
        float* d2 = row2 < MP ? p.out + O_YP + (size_t)row2 * D : p.out + O_YS + (size_t)(row2 - MP) * D;
#pragma unroll
        for (int i = 0; i < 8; ++i) {
          const f32x4 gg = ((const f32x4*)p.norm_final)[lane + 64 * i];
          __builtin_nontemporal_store(v[i] * sc1 * gg, (f32x4*)d1 + lane + 64 * i);
          if (has2) __builtin_nontemporal_store(u[i] * sc2 * gg, (f32x4*)d2 + lane + 64 * i);
        }
      }
    } break;
    default: break;
  }
}


#define XB_TMO      128
#define XB_XCNT(j)  (256  + 64 * (j))
#define XB_XSUB(j)  (1280 + 64 * (j))
#define XB_XGEN(j)  (2304 + 64 * (j))
#define XB_TOP      3328
#define XB_TOPGEN   3392
#define XCD_BAR_WORDS 3456
#define XB_SPIN_CAP (1u << 22)
#define LAS __attribute__((address_space(3)))
__device__ __forceinline__ unsigned xb_ld(unsigned* p) { return __hip_atomic_load(p, __ATOMIC_RELAXED, __HIP_MEMORY_SCOPE_AGENT); }
__device__ __forceinline__ unsigned xb_add(unsigned* p, unsigned v) { return __hip_atomic_fetch_add(p, v, __ATOMIC_RELAXED, __HIP_MEMORY_SCOPE_AGENT); }
__device__ __forceinline__ unsigned xb_xcc_id() { return (unsigned)__builtin_amdgcn_s_getreg((3 << 11) | 20) & 0xFu; }
#define XB_SPIN(cond, bar) do { unsigned _sp = 0; while (cond) { __builtin_amdgcn_s_sleep(1); \
    if ((++_sp & 255u) == 0u) { if (xb_ld(&(bar)[XB_TMO])) break; if (_sp > XB_SPIN_CAP) { atomicAdd(&(bar)[XB_TMO], 1u); break; } } } } while (0)

__device__ __forceinline__ void xcd_barrier_complete(unsigned* bar, unsigned x, unsigned& nloc, unsigned& nx) {
  const unsigned G = gridDim.x * gridDim.y * gridDim.z;
  unsigned sum, cnt, mine, sp = 0u;
  for (;;) {
    sum = 0u; cnt = 0u; mine = 0u;
#pragma unroll
    for (unsigned j = 0; j < 16; ++j) { const unsigned c = xb_ld(&bar[XB_XCNT(j)]); sum += c; cnt += (c > 0u) ? 1u : 0u; mine = (j == x) ? c : mine; }
    if (sum == G) break;
    __builtin_amdgcn_s_sleep(1);
    if ((++sp & 255u) == 0u) { if (xb_ld(&bar[XB_TMO])) break; if (sp > XB_SPIN_CAP) { atomicAdd(&bar[XB_TMO], 1u); break; } }
  }
  nloc = mine > 0u ? mine : 1u; nx = cnt > 0u ? cnt : 1u;
}

__device__ __forceinline__ void xcd_barrier(unsigned* bar, volatile LAS unsigned* st) {
  asm volatile("s_waitcnt vmcnt(0)" ::: "memory");
  __syncthreads();
  if (threadIdx.x == 0) {
    const unsigned x = xb_xcc_id();
    __builtin_amdgcn_s_waitcnt(0);
    unsigned nloc = st[0], nx = st[1];
    if (nloc == 0u) { xcd_barrier_complete(bar, x, nloc, nx); st[0] = nloc; st[1] = nx; }
    const unsigned old = xb_add(&bar[XB_XSUB(x)], 1u);
    const unsigned gen = old / nloc;
    if (old + 1u == (gen + 1u) * nloc) {
      __builtin_amdgcn_fence(__ATOMIC_RELEASE, "agent");
      asm volatile("s_waitcnt vmcnt(0)" ::: "memory");
      const unsigned og = xb_add(&bar[XB_TOP], 1u);
      const unsigned tg = og / nx;
      if (og + 1u == (tg + 1u) * nx) xb_add(&bar[XB_TOPGEN], 1u);
      else XB_SPIN(xb_ld(&bar[XB_TOPGEN]) == tg, bar);
      __builtin_amdgcn_fence(__ATOMIC_ACQUIRE, "agent");
      xb_add(&bar[XB_XGEN(x)], 1u);
      asm volatile("s_waitcnt vmcnt(0)" ::: "memory");
    } else {
      XB_SPIN(xb_ld(&bar[XB_XGEN(x)]) == gen, bar);
      __builtin_amdgcn_fence(__ATOMIC_ACQUIRE, "agent");
      asm volatile("s_waitcnt vmcnt(0)" ::: "memory");
    }
  }
  __syncthreads();
}

__constant__ int kOrder[NPHASE] = {0, 1, 2, 3, 4, 5, 6, 7, 9, 11, 13, 14, 20, 15, 17, 19, 21};

__global__ void __launch_bounds__(NTHREADS) mega_kernel(Params p_arg, int ph_begin, int ph_end, int coop) {
  extern __shared__ __attribute__((aligned(16))) char shm[];
  __shared__ uint4 xb_words;
  if (threadIdx.x == 0) {
    xb_words = make_uint4(0u, 0u, 0u, 0u);
    (void)xb_add(&((unsigned*)(p_arg.ws + WS_BAR))[XB_XCNT(xb_xcc_id())], 1u);
  }
  __syncthreads();
  int wv = __builtin_amdgcn_readfirstlane((int)(threadIdx.x >> 6));
  asm volatile("" : "+s"(wv));
  for (int i = ph_begin; i < ph_end; ++i) {
#if defined(__HIP_DEVICE_COMPILE__)
    Params p;
    load_params(p);
#else
    Params p = p_arg;
#endif
    int ph = kOrder[i];
    bool isg = (ph == 1) | (ph == 3) | (ph == 7) | (ph == 15) | (ph == 9) | (ph == 17) | (ph == 11) | (ph == 19) | (ph == 13);
    if (isg) gemm_phase(ph, shm, wv); else run_phase(p, ph, shm, wv);
    if (coop && i + 1 < ph_end) {
      if (coop == 2) {
        cg::this_grid().sync();
      } else {
        Params pb;
        load_params(pb);
        xcd_barrier((unsigned*)(pb.ws + WS_BAR), (volatile LAS unsigned*)&xb_words);
      }
    }
  }
}

extern "C" void kernel_launch(void* const* d_in, const int* in_sizes, int n_in, void* d_out, int out_size, void* d_ws,
                              size_t ws_size, hipStream_t stream) {
  static int grid_blocks = 0;
  if (!grid_blocks) {
    int dev = 0, cus = 0, per_cu = 0;
    hipGetDevice(&dev);
    hipDeviceGetAttribute(&cus, hipDeviceAttributeMultiprocessorCount, dev);
    hipFuncSetAttribute((const void*)mega_kernel, hipFuncAttributeMaxDynamicSharedMemorySize, SHM_BYTES);
    hipOccupancyMaxActiveBlocksPerMultiprocessor(&per_cu, mega_kernel, NTHREADS, SHM_BYTES);
    if (per_cu < 1) per_cu = 1;
    grid_blocks = cus * per_cu;
    if (grid_blocks > 256) grid_blocks = 256;
  }
  Params p{};
  const float** pp = (const float**)&p;
  for (int i = 0; i < 35; ++i) pp[i] = (const float*)d_in[i];
  p.out = (float*)d_out;
  p.ws = (char*)d_ws;
#ifdef MULTI_LAUNCH
  for (int i = 0; i < NPHASE; ++i) {
    hipLaunchKernelGGL(mega_kernel, dim3(grid_blocks), dim3(NTHREADS), SHM_BYTES, stream, p, i, i + 1, 0);
  }
#else
  hipMemsetAsync((char*)d_ws + WS_BAR, 0, XCD_BAR_WORDS * sizeof(unsigned), stream);
  int b = 0, e = NPHASE, c = 1;
  void* args[] = {&p, &b, &e, &c};
  hipError_t err = hipLaunchCooperativeKernel((void*)mega_kernel, dim3(grid_blocks), dim3(NTHREADS), args, SHM_BYTES, stream);
  if (err != hipSuccess) fprintf(stderr, "coop launch failed: %s\n", hipGetErrorString(err));
#endif
}
```
